# Optimizing an MI355X kernel written in HIP

```python
import math
import jax, jax.numpy as jnp
from jax import lax
import numpy as np

D_MODEL = 2048
BATCH = 4
SEQ = 2048
DEPTH = 1
DEC_BATCH = 128
DEC_SEQ = 8
PAST_LEN = 16384
PAGE_SIZE = 128

MIX_WIDTH = D_MODEL
RET_WIDTH = MIX_WIDTH // 2
CONV_WIDTH = MIX_WIDTH - RET_WIDTH
RET_HEADS = 8
RET_DIM = RET_WIDTH // RET_HEADS
RET_CHUNK = 128
CONV_K = 3
ROPE_BASE = 10000.0
N_MEM = 256
XA_HEADS = 4
XA_DIM = D_MODEL // XA_HEADS
D_FF = -(-8 * D_MODEL // (3 * 256)) * 256
IN_COLS = 4 * RET_WIDTH + 3 * CONV_WIDTH
RMS_EPS = 1e-6
GN_EPS = 1e-5

kernel_name = "hybrid_retention_shortconv_memxattn_step"


def rmsnorm(x, g):
    xf = x.astype(jnp.float32)
    y = xf * lax.rsqrt(jnp.mean(xf * xf, axis=-1, keepdims=True) + RMS_EPS)
    return (y * g.astype(jnp.float32)).astype(x.dtype)


def rotary(x, pos):
    half = x.shape[-1] // 2
    inv = ROPE_BASE ** (-jnp.arange(half, dtype=jnp.float32) / half)
    ang = pos.astype(jnp.float32)[:, None] * inv[None, :]
    cos = jnp.cos(ang)[None, :, None, :]
    sin = jnp.sin(ang)[None, :, None, :]
    x1, x2 = x[..., :half], x[..., half:]
    return jnp.concatenate([x1 * cos - x2 * sin, x1 * sin + x2 * cos], axis=-1)


def retention(q, k, v, s0):
    B, T, H, D = q.shape
    L = RET_CHUNK if T % RET_CHUNK == 0 else T
    n = T // L
    lg = jnp.log(1.0 - 2.0 ** (-5.0 - jnp.arange(H, dtype=jnp.float32)))
    idx = jnp.arange(L, dtype=jnp.float32)
    rel = idx[:, None] - idx[None, :]
    dmask = jnp.exp(jnp.where(rel[None] >= 0, rel[None] * lg[:, None, None], -jnp.inf))
    q_dec = jnp.exp((idx + 1.0)[:, None] * lg[None, :])
    k_dec = jnp.exp((L - 1.0 - idx)[:, None] * lg[None, :])
    chunk_dec = jnp.exp(L * lg)

    def to_chunks(t):
        return jnp.moveaxis(t.reshape(B, n, L, H, D), 1, 0)

    def step(s, inp):
        qc, kc, vc = inp
        scores = jnp.einsum('blhd,bmhd->bhlm', qc, kc) * dmask[None]
        inner = jnp.einsum('bhlm,bmhd->blhd', scores, vc)
        cross = jnp.einsum('blhd,bhde->blhe', qc, s) * q_dec[None, :, :, None]
        s_new = s * chunk_dec[None, :, None, None] + jnp.einsum(
            'blhd,blhe->bhde', kc * k_dec[None, :, :, None], vc)
        return s_new, inner + cross

    s_fin, out = lax.scan(step, s0, (to_chunks(q), to_chunks(k), to_chunks(v)))
    out = jnp.moveaxis(out, 0, 1).reshape(B, T, H, D)
    return out, s_fin


def mixer_sublayer(x, pos, s0, conv_buf, ln_g, w_in, conv_w, gn_g, w_out):
    B, T, _ = x.shape
    h = rmsnorm(x, ln_g)
    z = h @ w_in
    R, C = RET_WIDTH, CONV_WIDTH
    q, k, v, g, bg, cg, hin = jnp.split(
        z, [R, 2 * R, 3 * R, 4 * R, 4 * R + C, 4 * R + 2 * C], axis=-1)
    q = rotary(q.astype(jnp.float32).reshape(B, T, RET_HEADS, RET_DIM), pos)
    k = rotary(k.astype(jnp.float32).reshape(B, T, RET_HEADS, RET_DIM), pos) * (RET_DIM ** -0.5)
    v = v.astype(jnp.float32).reshape(B, T, RET_HEADS, RET_DIM)
    o, s_new = retention(q, k, v, s0.astype(jnp.float32))
    mu = jnp.mean(o, axis=-1, keepdims=True)
    var = jnp.mean(jnp.square(o - mu), axis=-1, keepdims=True)
    on = ((o - mu) * lax.rsqrt(var + GN_EPS)).reshape(B, T, R) * gn_g.astype(jnp.float32)
    ret_out = (jax.nn.silu(g.astype(jnp.float32)) * on).astype(x.dtype)
    u = cg * hin
    u_pad = jnp.concatenate([conv_buf.astype(u.dtype), u], axis=1)
    conv = (conv_w[0] * u_pad[:, :T] + conv_w[1] * u_pad[:, 1:T + 1]
            + conv_w[2] * u_pad[:, 2:T + 2])
    conv_out = bg * conv
    new_buf = u_pad[:, -(CONV_K - 1):]
    mix = jnp.concatenate([ret_out, conv_out], axis=-1) @ w_out
    return x + mix, s_new, new_buf


def memory_kv(mem, ln_mem_g, w_mk, w_mv):
    B, N, _ = mem.shape
    hm = rmsnorm(mem, ln_mem_g)
    mk = (hm @ w_mk).reshape(B, N, XA_HEADS, XA_DIM)
    mv = (hm @ w_mv).reshape(B, N, XA_HEADS, XA_DIM)
    return mk, mv


def memory_xattn_sublayer(x, ln_g, w_xq, w_xo, mk, mv):
    B, T, _ = x.shape
    h = rmsnorm(x, ln_g)
    q = (h @ w_xq).reshape(B, T, XA_HEADS, XA_DIM).astype(jnp.float32)
    s = jnp.einsum('bthd,bnhd->bhtn', q, mk.astype(jnp.float32)) * (XA_DIM ** -0.5)
    p = jax.nn.softmax(s, axis=-1)
    o = jnp.einsum('bhtn,bnhd->bthd', p, mv.astype(jnp.float32)).reshape(B, T, D_MODEL)
    return x + o.astype(x.dtype) @ w_xo


def ffn_sublayer(x, ln_g, w_gate, w_up, w_down):
    h = rmsnorm(x, ln_g)
    return x + (jax.nn.silu(h @ w_gate) * (h @ w_up)) @ w_down


def setup_inputs(seed: int = 0) -> dict:
    key = jax.random.key(seed)
    ks = jax.random.split(key, 24)
    f32 = jnp.float32

    def nrm(k, shape, scale=1.0):
        return jax.random.normal(k, shape, f32) * scale

    def gain(k, shape):
        return 1.0 + 0.05 * jax.random.normal(k, shape, f32)

    return {
        "x_prompt": nrm(ks[0], (BATCH, SEQ, D_MODEL)),
        "x_sample": nrm(ks[1], (DEC_BATCH, DEC_SEQ, D_MODEL)),
        "mem_prompt": nrm(ks[2], (BATCH, N_MEM, D_MODEL)),
        "state_ret": nrm(ks[3], (DEPTH, DEC_BATCH, RET_HEADS, RET_DIM, RET_DIM)),
        "state_conv": nrm(ks[4], (DEPTH, DEC_BATCH, CONV_K - 1, CONV_WIDTH)),
        "cache_mem_k": nrm(ks[5], (DEPTH, DEC_BATCH, N_MEM, XA_HEADS, XA_DIM)),
        "cache_mem_v": nrm(ks[6], (DEPTH, DEC_BATCH, N_MEM, XA_HEADS, XA_DIM)),
        "ln_mix_g": gain(ks[7], (DEPTH, D_MODEL)),
        "w_in": nrm(ks[8], (DEPTH, D_MODEL, IN_COLS), D_MODEL ** -0.5),
        "conv_w": nrm(ks[9], (DEPTH, CONV_K, CONV_WIDTH), CONV_K ** -0.5),
        "ret_gn_g": gain(ks[10], (DEPTH, RET_WIDTH)),
        "w_mix_out": nrm(ks[11], (DEPTH, MIX_WIDTH, D_MODEL), MIX_WIDTH ** -0.5),
        "ln_mem_g": gain(ks[12], (DEPTH, D_MODEL)),
        "ln_xa_g": gain(ks[13], (DEPTH, D_MODEL)),
        "w_xq": nrm(ks[14], (DEPTH, D_MODEL, D_MODEL), D_MODEL ** -0.5),
        "w_mk": nrm(ks[15], (DEPTH, D_MODEL, D_MODEL), D_MODEL ** -0.5),
        "w_mv": nrm(ks[16], (DEPTH, D_MODEL, D_MODEL), D_MODEL ** -0.5),
        "w_xo": nrm(ks[17], (DEPTH, D_MODEL, D_MODEL), D_MODEL ** -0.5),
        "ln_ffn_g": gain(ks[18], (DEPTH, D_MODEL)),
        "w_gate": nrm(ks[19], (DEPTH, D_MODEL, D_FF), D_MODEL ** -0.5),
        "w_up": nrm(ks[20], (DEPTH, D_MODEL, D_FF), D_MODEL ** -0.5),
        "w_down": nrm(ks[21], (DEPTH, D_FF, D_MODEL), D_FF ** -0.5),
        "final_g": gain(ks[22], (D_MODEL,)),
    }


def reference(x_prompt, x_sample, mem_prompt, state_ret, state_conv, cache_mem_k, cache_mem_v,
              ln_mix_g, w_in, conv_w, ret_gn_g, w_mix_out, ln_mem_g, ln_xa_g, w_xq, w_mk, w_mv,
              w_xo, ln_ffn_g, w_gate, w_up, w_down, final_g):
    Bp, Tp, _ = x_prompt.shape
    Bs, Ts, _ = x_sample.shape
    pos_p = jnp.arange(Tp, dtype=jnp.int32)
    pos_s = PAST_LEN + jnp.arange(Ts, dtype=jnp.int32)
    yp, ys = x_prompt, x_sample
    ret_p, ret_s, conv_p, conv_s, mk_p_all, mv_p_all = [], [], [], [], [], []
    for l in range(DEPTH):
        s0_p = jnp.zeros((Bp, RET_HEADS, RET_DIM, RET_DIM), jnp.float32)
        buf0_p = jnp.zeros((Bp, CONV_K - 1, CONV_WIDTH), x_prompt.dtype)
        yp, sp, cp = mixer_sublayer(yp, pos_p, s0_p, buf0_p, ln_mix_g[l], w_in[l], conv_w[l],
                                    ret_gn_g[l], w_mix_out[l])
        ys, ss, cs = mixer_sublayer(ys, pos_s, state_ret[l], state_conv[l], ln_mix_g[l], w_in[l],
                                    conv_w[l], ret_gn_g[l], w_mix_out[l])
        mk_p, mv_p = memory_kv(mem_prompt, ln_mem_g[l], w_mk[l], w_mv[l])
        yp = memory_xattn_sublayer(yp, ln_xa_g[l], w_xq[l], w_xo[l], mk_p, mv_p)
        ys = memory_xattn_sublayer(ys, ln_xa_g[l], w_xq[l], w_xo[l], cache_mem_k[l], cache_mem_v[l])
        yp = ffn_sublayer(yp, ln_ffn_g[l], w_gate[l], w_up[l], w_down[l])
        ys = ffn_sublayer(ys, ln_ffn_g[l], w_gate[l], w_up[l], w_down[l])
        ret_p.append(sp)
        ret_s.append(ss)
        conv_p.append(cp)
        conv_s.append(cs)
        mk_p_all.append(mk_p)
        mv_p_all.append(mv_p)
    y_prompt = rmsnorm(yp, final_g)
    y_sample = rmsnorm(ys, final_g)
    state_ret_prompt = jnp.stack(ret_p)
    state_ret_sample = jnp.stack(ret_s)
    state_conv_prompt = jnp.stack(conv_p)
    state_conv_sample = jnp.stack(conv_s)
    cache_mem_k_prompt = jnp.stack(mk_p_all)
    cache_mem_v_prompt = jnp.stack(mv_p_all)
    return (y_prompt, y_sample, state_ret_prompt, state_ret_sample, state_conv_prompt,
            state_conv_sample, cache_mem_k_prompt, cache_mem_v_prompt)
```

```cpp
#include <hip/hip_runtime.h>
#include <hip/hip_cooperative_groups.h>
#include <cstdio>
#include <cstdint>
namespace cg = cooperative_groups;

#define LAS __attribute__((address_space(3)))
typedef unsigned short bf16_t;
typedef short bf16x8 __attribute__((ext_vector_type(8)));
typedef float f32x4 __attribute__((ext_vector_type(4)));
typedef float f32x2 __attribute__((ext_vector_type(2)));
typedef unsigned u32x4 __attribute__((ext_vector_type(4)));
typedef unsigned u32x2 __attribute__((ext_vector_type(2)));

constexpr int DM = 2048, TP = 2048, BP = 4, MP = BP * TP, BS = 128, TS = 8, MS = BS * TS, MT = MP + MS;
constexpr int INC = 7168, RH = 8, RD = 128, NMEM = 256, XH = 4, XD = 512, DFF = 5632, PAST = 16384;
constexpr int ZQ = 0, ZK = 1024, ZV = 2048, ZG = 3072, ZBG = 4096, ZCG = 5120, ZHIN = 6144;
constexpr float RMS_EPS = 1e-6f, GN_EPS = 1e-5f;
constexpr float QSCALE = 0.04419417382415922f * 1.4426950408889634f;
constexpr float KSCALE = 0.08838834764831845f;
constexpr size_t O_Y = 0, O_SRP = (size_t)MT * DM, O_SRS = O_SRP + (size_t)BP * RH * RD * RD, O_SCP = O_SRS + (size_t)BS * RH * RD * RD,
                 O_SCS = O_SCP + (size_t)BP * 2 * 1024, O_MK = O_SCS + (size_t)BS * 2 * 1024, O_MV = O_MK + (size_t)BP * NMEM * DM;
constexpr size_t MiB = 1u << 20;
constexpr size_t WS_CTL = 0, WS_ROPE = 1 * MiB, WS_WIN = 4 * MiB, WS_WMO = WS_WIN + 28 * MiB, WS_WXQ = WS_WMO + 8 * MiB, WS_WXO = WS_WXQ + 8 * MiB,
                 WS_WMKV = WS_WXO + 8 * MiB, WS_WGU = WS_WMKV + 16 * MiB, WS_WD = WS_WGU + 44 * MiB, WS_H1 = WS_WD + 22 * MiB, WS_HM = WS_H1 + 36 * MiB,
                 WS_Z = WS_HM + 4 * MiB, WS_MIX = WS_Z + 126 * MiB, WS_X = WS_MIX + 36 * MiB, WS_X1B = WS_X + 72 * MiB, WS_Q = WS_X1B + 36 * MiB,
                 WS_P = WS_Q + 36 * MiB, WS_AO = WS_P + 16 * MiB, WS_X2B = WS_AO + 36 * MiB, WS_HFF = WS_X2B + 36 * MiB, WS_KV = WS_HFF + 99 * MiB,
                 WS_MKB = WS_KV + 32 * MiB, WS_VT = WS_MKB + 4 * MiB, WS_END = WS_VT + 4 * MiB;
constexpr int CW_SSQ1 = 0, CW_SSQ2 = 16384, CW_SSQ3 = 32768, CW_ATT = 49152, CW_N = 49152 + 64;
constexpr int LDS_BYTES = 147456;
constexpr int NTHR = 512;

__device__ __forceinline__ unsigned f2bf(float f) { unsigned u = __builtin_bit_cast(unsigned, f); return (u + 0x7fffu + ((u >> 16) & 1u)) >> 16; }
__device__ __forceinline__ float bf2f(unsigned short h) { return __builtin_bit_cast(float, (unsigned)h << 16); }
__device__ __forceinline__ unsigned pk2(float lo, float hi) { unsigned r; asm volatile("v_cvt_pk_bf16_f32 %0, %1, %2" : "=v"(r) : "v"(lo), "v"(hi)); return r; }
__device__ __forceinline__ float bflo(unsigned w) { return __builtin_bit_cast(float, w << 16); }
__device__ __forceinline__ float bfhi(unsigned w) { return __builtin_bit_cast(float, w & 0xffff0000u); }
__device__ __forceinline__ float wave_sum(float v) {
#pragma unroll
    for (int o = 1; o < 64; o <<= 1) v += __shfl_xor(v, o);
    return v;
}
__device__ __forceinline__ float wave_max(float v) {
#pragma unroll
    for (int o = 1; o < 64; o <<= 1) v = fmaxf(v, __shfl_xor(v, o));
    return v;
}
__device__ __forceinline__ float silu_f(float x) { return x * __builtin_amdgcn_rcpf(1.0f + __builtin_amdgcn_exp2f(-1.4426950408889634f * x)); }
#define LDS_WAIT() asm volatile("s_waitcnt lgkmcnt(0)" ::: "memory")

namespace pg8 {
constexpr int BM = 256, BK = 64, HALF = 128, HTB = HALF * BK * 2, STAGE_BYTES = 8 * HTB, NXCD = 8, WGM = 8;
__host__ __device__ __forceinline__ int lds_byte(int r, int c) { const int st = (r >> 4) * 2 + (c >> 5), rr = r & 15, cc = c & 31, ob = rr * 64 + cc * 2; return st * 1024 + (ob ^ (((ob >> 9) & 1) << 5)); }
__host__ __device__ __forceinline__ void stage_rc(int b, int& R, int& C) { const int st = b / 1024, sb = b % 1024, swz = sb ^ (((sb >> 9) & 1) << 5); R = (st >> 1) * 16 + swz / 64; C = (st & 1) * 32 + (swz % 64) / 2; }
__host__ __device__ __forceinline__ int perm32(int rho) { const int n = rho >> 4, i = rho & 15; return 8 * (i >> 2) + 4 * n + (i & 3); }

struct Unit { int pm, pn; };
struct Gemm { const bf16_t* A; const bf16_t* Bt; int lda, ldb, K; };

struct StaticOrder {
    int nM, nN, nwg, G, c;
    __device__ void init(int M, int N, int G_, int c_) { nM = M / BM; nN = N / BM; nwg = nM * nN; G = G_; c = c_; }
    __device__ bool next(int i, Unit& u) const {
        const long L = (long)i * G + c; if (L >= nwg) return false;
        int wgid = (int)L; { const int q = nwg / NXCD, r = nwg % NXCD, xcd = wgid % NXCD, off = wgid / NXCD; wgid = (xcd < r ? xcd * (q + 1) : r * (q + 1) + (xcd - r) * q) + off; }
        const int nig = WGM * nN, gid = wgid / nig, fm = gid * WGM, gsz = (nM - fm) < WGM ? (nM - fm) : WGM;
        u.pm = fm + ((wgid % nig) % gsz); u.pn = (wgid % nig) / gsz; return true;
    }
};
struct ListOrder {
    int pm, pn0, n;
    __device__ bool next(int i, Unit& u) const { if (i >= n) return false; u.pm = pm; u.pn = pn0 + i; return true; }
};

template <class Epi, class Sched, bool ALIGN_EPI>
__device__ __forceinline__ void gemm_phase(LAS unsigned char* lds, const Gemm g, const Sched& S, const Epi& E) {
    const int tid = threadIdx.x, wid = __builtin_amdgcn_readfirstlane(tid >> 6), lane = tid & 63, wr = wid >> 2, wc = wid & 3, fr = lane & 15, fq = lane >> 4;
    int Kop = g.K; asm volatile("" : "+s"(Kop));
    const int K = Kop, nt = K / BK;
    unsigned voffA[2], voffB[2];
#pragma unroll
    for (int i = 0; i < 2; ++i) { int R, C; stage_rc(tid * 16 + i * 8192, R, C); const int Rb = Epi::PERM ? ((R & ~31) + perm32(R & 31)) : R;
        voffA[i] = (unsigned)(R * g.lda + C) * 2u; voffB[i] = (unsigned)(Rb * g.ldb + C) * 2u; }
    const size_t kstep = (size_t)(BK * 2);
    const size_t hstepA = (size_t)HALF * g.lda * 2, hstepB = (size_t)HALF * g.ldb * 2;
    const size_t tstepA = 2 * hstepA, tstepB = 2 * hstepB;
    const unsigned ldsw = (unsigned)wid * 1024u;
    const int aoff = lds_byte(wr * 64 + fr, fq * 8), boff = lds_byte(wc * 32 + fr, fq * 8);
#define PG8_SA(b, h) (((b) * 2 + (h)) * HTB)
#define PG8_SB(b, h) ((4 + (b) * 2 + (h)) * HTB)
#define PG8_STAGE(bufoff, gbase, voff) do { _Pragma("unroll") for (int _i = 0; _i < 2; ++_i) \
        __builtin_amdgcn_global_load_lds((const unsigned*)((const char*)(gbase) + (voff)[_i]), (LAS unsigned*)(lds + (bufoff) + ldsw + _i * 8192), 16, 0, 0); } while (0)
#define PG8_LDA(dst, b, h) do { _Pragma("unroll") for (int m = 0; m < 4; ++m) _Pragma("unroll") for (int k = 0; k < 2; ++k) dst[m][k] = *(const LAS bf16x8*)(lds + PG8_SA(b, h) + aoff + m * 2048 + k * 1024); } while (0)
#define PG8_LDB(dst, b, h) do { _Pragma("unroll") for (int n = 0; n < 2; ++n) _Pragma("unroll") for (int k = 0; k < 2; ++k) dst[n][k] = *(const LAS bf16x8*)(lds + PG8_SB(b, h) + boff + n * 2048 + k * 1024); } while (0)
#define PG8_MMA(ai, bj, At, Bt) do { __builtin_amdgcn_s_setprio(1); _Pragma("unroll") for (int m = 0; m < 4; ++m) _Pragma("unroll") for (int n = 0; n < 2; ++n) _Pragma("unroll") for (int k = 0; k < 2; ++k) \
        acc[ai][bj][m][n] = __builtin_amdgcn_mfma_f32_16x16x32_bf16(Bt[n][k], At[m][k], acc[ai][bj][m][n], 0, 0, 0); __builtin_amdgcn_s_setprio(0); } while (0)
#define PG8_WAIT_V(n) asm volatile("s_waitcnt vmcnt(" #n ")" ::: "memory")
#define PG8_WAIT_L(n) asm volatile("s_waitcnt lgkmcnt(" #n ")" ::: "memory")
#define PG8_BAR __builtin_amdgcn_s_barrier()
#define PG8_SCHED __builtin_amdgcn_sched_barrier(0)
    Unit cur, nxt; int ui = 0;
    if (!S.next(0, cur)) return;
    f32x4 acc[2][2][4][2];
#pragma unroll
    for (int a = 0; a < 2; ++a)
#pragma unroll
        for (int b = 0; b < 2; ++b)
#pragma unroll
            for (int m = 0; m < 4; ++m)
#pragma unroll
                for (int n = 0; n < 2; ++n) acc[a][b][m][n] = (f32x4){0.f, 0.f, 0.f, 0.f};
    bf16x8 At[4][2], B0[2][2], B1[2][2];
    const char* cA = (const char*)g.A + (size_t)cur.pm * tstepA; const char* cB = (const char*)g.Bt + (size_t)cur.pn * tstepB;
    PG8_STAGE(PG8_SB(0, 0), cB, voffB); PG8_STAGE(PG8_SB(0, 1), cB + hstepB, voffB); PG8_STAGE(PG8_SA(0, 0), cA, voffA); PG8_STAGE(PG8_SA(0, 1), cA + hstepA, voffA);
    if (wr == 1) PG8_BAR;
    PG8_WAIT_V(2); PG8_BAR;
    PG8_STAGE(PG8_SB(1, 0), cB + kstep, voffB); PG8_STAGE(PG8_SA(1, 0), cA + kstep, voffA); PG8_STAGE(PG8_SB(1, 1), cB + hstepB + kstep, voffB);
    PG8_WAIT_V(6); PG8_BAR;
    for (;;) {
        const bool has_next = S.next(ui + 1, nxt);
        const char* nA = has_next ? (const char*)g.A + (size_t)nxt.pm * tstepA : cA; const char* nB = has_next ? (const char*)g.Bt + (size_t)nxt.pn * tstepB : cB;
        for (int t = 0; t < nt; t += 2) {
            const bool last = (t == nt - 2);
            const char* a1 = cA + (size_t)(t + 1) * kstep;
            const char* a2 = last ? nA : cA + (size_t)(t + 2) * kstep; const char* b2 = last ? nB : cB + (size_t)(t + 2) * kstep;
            const char* a3 = a2 + kstep; const char* b3 = b2 + kstep;
            PG8_LDB(B0, 0, 0); PG8_LDB(B1, 0, 1); PG8_SCHED; PG8_LDA(At, 0, 0); PG8_STAGE(PG8_SA(1, 1), a1 + hstepA, voffA);
            PG8_WAIT_V(8); PG8_WAIT_L(0); PG8_BAR; PG8_MMA(0, 0, At, B0); PG8_MMA(0, 1, At, B1); PG8_BAR; PG8_SCHED;
            PG8_LDA(At, 0, 1); PG8_STAGE(PG8_SB(0, 0), b2, voffB); PG8_STAGE(PG8_SB(0, 1), b2 + hstepB, voffB); PG8_STAGE(PG8_SA(0, 0), a2, voffA);
            PG8_WAIT_V(8); PG8_WAIT_L(0); PG8_BAR; PG8_MMA(1, 0, At, B0); PG8_MMA(1, 1, At, B1); PG8_BAR; PG8_SCHED;
            PG8_LDB(B0, 1, 0); PG8_LDB(B1, 1, 1); PG8_SCHED; PG8_LDA(At, 1, 0); PG8_STAGE(PG8_SA(0, 1), a2 + hstepA, voffA);
            PG8_WAIT_V(8); PG8_WAIT_L(0); PG8_BAR; PG8_MMA(0, 0, At, B0); PG8_MMA(0, 1, At, B1); PG8_BAR; PG8_SCHED;
            PG8_LDA(At, 1, 1); PG8_STAGE(PG8_SB(1, 0), b3, voffB); PG8_STAGE(PG8_SB(1, 1), b3 + hstepB, voffB); PG8_STAGE(PG8_SA(1, 0), a3, voffA);
            PG8_WAIT_V(8); PG8_WAIT_L(0); PG8_BAR; PG8_MMA(1, 0, At, B0); PG8_MMA(1, 1, At, B1); PG8_BAR; PG8_SCHED;
        }
        if constexpr (ALIGN_EPI) { if (wr == 0) PG8_BAR; }
        if constexpr (!Epi::AFTER_DRAIN) { E(acc, cur, wr, wc, fr, fq); }
        if (!has_next) break;
#pragma unroll
        for (int a = 0; a < 2; ++a)
#pragma unroll
            for (int b = 0; b < 2; ++b)
#pragma unroll
                for (int m = 0; m < 4; ++m)
#pragma unroll
                    for (int n = 0; n < 2; ++n) acc[a][b][m][n] = (f32x4){0.f, 0.f, 0.f, 0.f};
        cur = nxt; cA = nA; cB = nB; ++ui;
        if constexpr (ALIGN_EPI) { if (wr == 1) PG8_BAR; }
    }
    PG8_WAIT_V(0);
    if constexpr (!ALIGN_EPI) { if (wr == 0) PG8_BAR; }
    PG8_BAR;
    if constexpr (Epi::AFTER_DRAIN) { E.fused(acc, cur, wr, wc, fr, fq, lds, wid, lane); }
#undef PG8_SA
#undef PG8_SB
#undef PG8_STAGE
#undef PG8_LDA
#undef PG8_LDB
#undef PG8_MMA
#undef PG8_WAIT_V
#undef PG8_WAIT_L
#undef PG8_BAR
#undef PG8_SCHED
}

typedef f32x4 Acc[2][2][4][2];

struct EpiBf16 {
    static constexpr bool PERM = true, AFTER_DRAIN = false;
    bf16_t* O; int ldc; const float* ssq; float mul;
    __device__ __forceinline__ void operator()(const Acc& acc, const Unit& u, int wr, int wc, int fr, int fq) const {
        const int row0 = u.pm * BM + wr * 64 + fr, col0 = u.pn * BM + wc * 32 + 8 * fq;
#pragma unroll
        for (int ai = 0; ai < 2; ++ai)
#pragma unroll
            for (int m = 0; m < 4; ++m) { const int row = row0 + ai * HALF + m * 16; bf16_t* rowp = O + (size_t)row * ldc + col0;
                float sc = mul; if (ssq) sc *= rsqrtf(ssq[row] * (1.0f / DM) + RMS_EPS);
#pragma unroll
                for (int bj = 0; bj < 2; ++bj) { const f32x4 v0 = acc[ai][bj][m][0] * sc, v1 = acc[ai][bj][m][1] * sc;
                    u32x4 w; w.x = pk2(v0[0], v0[1]); w.y = pk2(v0[2], v0[3]); w.z = pk2(v1[0], v1[1]); w.w = pk2(v1[2], v1[3]);
                    *(u32x4*)(rowp + bj * HALF) = w; } }
    }
};
struct EpiSwiglu {
    static constexpr bool PERM = true, AFTER_DRAIN = false;
    bf16_t* O; const float* ssq;
    __device__ __forceinline__ void operator()(const Acc& acc, const Unit& u, int wr, int wc, int fr, int fq) const {
        const int row0 = u.pm * BM + wr * 64 + fr, col0 = u.pn * HALF + wc * 32 + 8 * fq;
#pragma unroll
        for (int ai = 0; ai < 2; ++ai)
#pragma unroll
            for (int m = 0; m < 4; ++m) { const int row = row0 + ai * HALF + m * 16;
                const float rs = rsqrtf(ssq[row] * (1.0f / DM) + RMS_EPS);
                float h[8];
#pragma unroll
                for (int n = 0; n < 2; ++n)
#pragma unroll
                    for (int e = 0; e < 4; ++e) { const float gg = acc[ai][0][m][n][e] * rs, uu = acc[ai][1][m][n][e] * rs; h[n * 4 + e] = silu_f(gg) * uu; }
                u32x4 w; w.x = pk2(h[0], h[1]); w.y = pk2(h[2], h[3]); w.z = pk2(h[4], h[5]); w.w = pk2(h[6], h[7]);
                *(u32x4*)(O + (size_t)row * DFF + col0) = w; }
    }
};
struct EpiRes {
    static constexpr bool PERM = false, AFTER_DRAIN = false;
    const float* res_p; const float* res_s;
    float* out; bf16_t* xb; float* ssq;
    __device__ __forceinline__ void operator()(const Acc& acc, const Unit& u, int wr, int wc, int fr, int fq) const {
        const int col0 = u.pn * BM + wc * 32 + 4 * fq;
        const float* rbase = (u.pm * BM < MP) ? res_p : (res_s - (size_t)MP * DM);
#pragma unroll
        for (int ai = 0; ai < 2; ++ai)
#pragma unroll
            for (int m = 0; m < 4; ++m) { const int row = u.pm * BM + ai * HALF + wr * 64 + m * 16 + fr; const size_t off = (size_t)row * DM + col0; float ss = 0.f;
#pragma unroll
                for (int bj = 0; bj < 2; ++bj)
#pragma unroll
                    for (int n = 0; n < 2; ++n) { const size_t o2 = off + bj * HALF + n * 16; const f32x4 bs = *(const f32x4*)(rbase + o2); const f32x4 o = bs + acc[ai][bj][m][n];
                        ss += (o[0] * o[0] + o[1] * o[1]) + (o[2] * o[2] + o[3] * o[3]);
                        *(f32x4*)(out + o2) = o;
                        if (xb) { u32x2 w; w.x = pk2(o[0], o[1]); w.y = pk2(o[2], o[3]); *(u32x2*)(xb + o2) = w; } }
                ss += __shfl_xor(ss, 16); ss += __shfl_xor(ss, 32);
                if (fq == 0) unsafeAtomicAdd(ssq + row, ss);
                asm volatile("" ::: "memory"); }
    }
};
struct EpiMemKV {
    static constexpr bool PERM = false, AFTER_DRAIN = false;
    float* outk; float* outv; bf16_t* mkb; bf16_t* vt;
    __device__ __forceinline__ void operator()(const Acc& acc, const Unit& u, int wr, int wc, int fr, int fq) const {
        const int col0 = u.pn * BM + wc * 32 + 4 * fq; const bool isv = col0 >= DM;
#pragma unroll
        for (int ai = 0; ai < 2; ++ai)
#pragma unroll
            for (int m = 0; m < 4; ++m) { const int row = u.pm * BM + ai * HALF + wr * 64 + m * 16 + fr;
#pragma unroll
                for (int bj = 0; bj < 2; ++bj)
#pragma unroll
                    for (int n = 0; n < 2; ++n) { const int c = col0 + bj * HALF + n * 16; const f32x4 o = acc[ai][bj][m][n];
                        if (!isv) { *(f32x4*)(outk + (size_t)row * DM + c) = o; u32x2 w; w.x = pk2(o[0], o[1]); w.y = pk2(o[2], o[3]); *(u32x2*)(mkb + (size_t)row * DM + c) = w; }
                        else { const int cv = c - DM; *(f32x4*)(outv + (size_t)row * DM + cv) = o; const int b = row >> 8, key = row & 255, h = cv >> 9, d = cv & 511;
                            bf16_t* p = vt + ((size_t)((b * XH + h) * XD + d)) * NMEM + key;
                            p[0] = (bf16_t)f2bf(o[0]); p[NMEM] = (bf16_t)f2bf(o[1]); p[2 * NMEM] = (bf16_t)f2bf(o[2]); p[3 * NMEM] = (bf16_t)f2bf(o[3]); } } }
    }
};
struct EpiSoftmax {
    static constexpr bool PERM = true, AFTER_DRAIN = true;
    bf16_t* P; int h;
    __device__ __forceinline__ void fused(Acc& acc, const Unit& u, int wr, int wc, int fr, int fq, LAS unsigned char* lds, int wid, int lane) const {
        LAS float* red = (LAS float*)lds; LAS float* red2 = red + 1024;
#pragma unroll
        for (int ai = 0; ai < 2; ++ai)
#pragma unroll
            for (int m = 0; m < 4; ++m) { float v = -3.0e38f;
#pragma unroll
                for (int bj = 0; bj < 2; ++bj)
#pragma unroll
                    for (int n = 0; n < 2; ++n) { const f32x4 x = acc[ai][bj][m][n]; v = fmaxf(v, fmaxf(fmaxf(x[0], x[1]), fmaxf(x[2], x[3]))); }
                v = fmaxf(v, __shfl_xor(v, 16)); v = fmaxf(v, __shfl_xor(v, 32));
                if (fq == 0) red[(ai * HALF + wr * 64 + m * 16 + fr) * 4 + wc] = v; }
        LDS_WAIT(); __builtin_amdgcn_s_barrier(); asm volatile("" ::: "memory");
#pragma unroll
        for (int ai = 0; ai < 2; ++ai)
#pragma unroll
            for (int m = 0; m < 4; ++m) { const int r = ai * HALF + wr * 64 + m * 16 + fr; const f32x4 t = *(const LAS f32x4*)(red + r * 4);
                const float mx = fmaxf(fmaxf(t[0], t[1]), fmaxf(t[2], t[3])); float s = 0.f;
#pragma unroll
                for (int bj = 0; bj < 2; ++bj)
#pragma unroll
                    for (int n = 0; n < 2; ++n) { f32x4 x = acc[ai][bj][m][n];
#pragma unroll
                        for (int e = 0; e < 4; ++e) { x[e] = __builtin_amdgcn_exp2f(x[e] - mx); s += x[e]; }
                        acc[ai][bj][m][n] = x; }
                s += __shfl_xor(s, 16); s += __shfl_xor(s, 32);
                if (fq == 0) red2[r * 4 + wc] = s; }
        LDS_WAIT(); __builtin_amdgcn_s_barrier(); asm volatile("" ::: "memory");
        const int b = u.pm >> 3, rb = u.pm & 7;
#pragma unroll
        for (int ai = 0; ai < 2; ++ai)
#pragma unroll
            for (int m = 0; m < 4; ++m) { const int r = ai * HALF + wr * 64 + m * 16 + fr; const f32x4 t = *(const LAS f32x4*)(red2 + r * 4);
                const float inv = 1.0f / ((t[0] + t[1]) + (t[2] + t[3]));
                bf16_t* rowp = P + ((size_t)((b * XH + h) * TP + rb * BM + r)) * NMEM + wc * 32 + 8 * fq;
#pragma unroll
                for (int bj = 0; bj < 2; ++bj) { const f32x4 v0 = acc[ai][bj][m][0] * inv, v1 = acc[ai][bj][m][1] * inv;
                    u32x4 w; w.x = pk2(v0[0], v0[1]); w.y = pk2(v0[2], v0[3]); w.z = pk2(v1[0], v1[1]); w.w = pk2(v1[2], v1[3]);
                    *(u32x4*)(rowp + bj * HALF) = w; } }
        LDS_WAIT(); __builtin_amdgcn_s_barrier(); asm volatile("" ::: "memory");
    }
};
struct EpiPV {
    static constexpr bool PERM = true, AFTER_DRAIN = false;
    bf16_t* AO;
    __device__ __forceinline__ void operator()(const Acc& acc, const Unit& u, int wr, int wc, int fr, int fq) const {
        const int bh = u.pm >> 3, rb = u.pm & 7, b = bh >> 2, h = bh & 3, ct = u.pn & 1;
        const int row0 = b * TP + rb * BM + wr * 64 + fr, col0 = h * XD + ct * BM + wc * 32 + 8 * fq;
#pragma unroll
        for (int ai = 0; ai < 2; ++ai)
#pragma unroll
            for (int m = 0; m < 4; ++m) { bf16_t* rowp = AO + (size_t)(row0 + ai * HALF + m * 16) * DM + col0;
#pragma unroll
                for (int bj = 0; bj < 2; ++bj) { const f32x4 v0 = acc[ai][bj][m][0], v1 = acc[ai][bj][m][1];
                    u32x4 w; w.x = pk2(v0[0], v0[1]); w.y = pk2(v0[2], v0[3]); w.z = pk2(v1[0], v1[1]); w.w = pk2(v1[2], v1[3]);
                    *(u32x4*)(rowp + bj * HALF) = w; } }
    }
};
}

struct Args { const float* in[23]; float* out; unsigned char* ws; int lo, hi, coop, pad; };

__device__ __forceinline__ void transpose_item(const float* W, int K, int N, bf16_t* WT, int drow0, const float* gain, LAS float* scr, int k0, int n0, int lane) {
#pragma unroll 8
    for (int i = 0; i < 32; ++i) { const int kk = 2 * i + (lane >> 5); float w = W[(size_t)(k0 + kk) * N + n0 + (lane & 31)]; if (gain) w *= gain[k0 + kk]; scr[kk * 33 + (lane & 31)] = w; }
    LDS_WAIT(); asm volatile("" ::: "memory");
    const int c = lane & 7;
#pragma unroll
    for (int j = 0; j < 4; ++j) { const int n = (lane >> 3) + 8 * j; const LAS float* s = scr + (8 * c) * 33 + n;
        u32x4 o; o.x = pk2(s[0 * 33], s[1 * 33]); o.y = pk2(s[2 * 33], s[3 * 33]); o.z = pk2(s[4 * 33], s[5 * 33]); o.w = pk2(s[6 * 33], s[7 * 33]);
        *(u32x4*)(WT + (size_t)(drow0 + n) * K + k0 + 8 * c) = o; }
    LDS_WAIT(); asm volatile("" ::: "memory");
}
__device__ __forceinline__ void rms_row_bf16(const float* x, const float* g, bf16_t* o, int lane) {
    const f32x4* xr = (const f32x4*)x + lane; f32x4 v[8]; float s = 0.f;
#pragma unroll
    for (int j = 0; j < 8; ++j) { v[j] = xr[64 * j]; s += (v[j][0] * v[j][0] + v[j][1] * v[j][1]) + (v[j][2] * v[j][2] + v[j][3] * v[j][3]); }
    const float rstd = rsqrtf(wave_sum(s) * (1.0f / DM) + RMS_EPS);
    const f32x4* gr = (const f32x4*)g + lane; u32x2* o8 = (u32x2*)o + lane;
#pragma unroll
    for (int j = 0; j < 8; ++j) { const f32x4 gg = gr[64 * j]; u32x2 w; w.x = pk2(v[j][0] * rstd * gg[0], v[j][1] * rstd * gg[1]); w.y = pk2(v[j][2] * rstd * gg[2], v[j][3] * rstd * gg[3]); o8[64 * j] = w; }
}
__device__ __forceinline__ void p0_prologue(const Args& a, LAS unsigned char* lds) {
    const int tid = threadIdx.x, lane = tid & 63, wave = tid >> 6, G = gridDim.x;
    unsigned char* ws = a.ws;
    { unsigned* ctl = (unsigned*)(ws + WS_CTL); for (int i = blockIdx.x * NTHR + tid; i < CW_N; i += G * NTHR) ctl[i] = 0u; }
    { float* rc = (float*)(ws + WS_ROPE); float* rs = rc + 2056 * 64;
      for (int i = blockIdx.x * NTHR + tid; i < 2056 * 64; i += G * NTHR) { const int idx = i >> 6, f = i & 63; const int pos = idx < 2048 ? idx : PAST + idx - 2048;
          const float inv = exp2f(-(float)f * (13.287712379549449f / 64.0f)); const float ang = (float)pos * inv;
          const double ad = (double)ang; const double k = __builtin_rint(ad * 0.15915494309189535); const float r = (float)(ad - k * 6.283185307179586);
          rc[i] = cosf(r); rs[i] = sinf(r); } }
    LAS float* scr = (LAS float*)(lds + wave * 16384);
    const int gw = blockIdx.x * 8 + wave, NGW = G * 8;
    constexpr int I_IN = 32 * 224, I_SQ = 32 * 64, I_FF = 32 * 176, I_DN = 88 * 64;
    constexpr int NITEMS = I_IN + 5 * I_SQ + 2 * I_FF + I_DN;
    for (int it = gw; it < NITEMS; it += NGW) {
        int r = it;
        if (r < I_IN) { const int kb = r / 224, nb = r % 224; transpose_item(a.in[8], DM, INC, (bf16_t*)(ws + WS_WIN), nb * 32, nullptr, scr, kb * 64, nb * 32, lane); continue; } r -= I_IN;
        if (r < 5 * I_SQ) { const int w = r / I_SQ, q = r % I_SQ, kb = q / 64, nb = q % 64;
            const float* src; bf16_t* dst; const float* gain = nullptr; int roff = 0;
            if (w == 0) { src = a.in[11]; dst = (bf16_t*)(ws + WS_WMO); }
            else if (w == 1) { src = a.in[14]; dst = (bf16_t*)(ws + WS_WXQ); gain = a.in[13]; }
            else if (w == 2) { src = a.in[15]; dst = (bf16_t*)(ws + WS_WMKV); }
            else if (w == 3) { src = a.in[16]; dst = (bf16_t*)(ws + WS_WMKV); roff = DM; }
            else { src = a.in[17]; dst = (bf16_t*)(ws + WS_WXO); }
            transpose_item(src, DM, DM, dst, roff + nb * 32, gain, scr, kb * 64, nb * 32, lane); continue; } r -= 5 * I_SQ;
        if (r < 2 * I_FF) { const int w = r / I_FF, q = r % I_FF, kb = q / 176, nb = q % 176, n0 = nb * 32;
            transpose_item(w == 0 ? a.in[19] : a.in[20], DM, DFF, (bf16_t*)(ws + WS_WGU), (n0 >> 7) * 256 + w * 128 + (n0 & 127), a.in[18], scr, kb * 64, n0, lane); continue; } r -= 2 * I_FF;
        { const int kb = r / 64, nb = r % 64; transpose_item(a.in[21], DFF, DM, (bf16_t*)(ws + WS_WD), nb * 32, nullptr, scr, kb * 64, nb * 32, lane); }
    }
    for (int m = gw; m < MT + BP * NMEM; m += NGW) {
        if (m < MP) rms_row_bf16(a.in[0] + (size_t)m * DM, a.in[7], (bf16_t*)(ws + WS_H1) + (size_t)m * DM, lane);
        else if (m < MT) rms_row_bf16(a.in[1] + (size_t)(m - MP) * DM, a.in[7], (bf16_t*)(ws + WS_H1) + (size_t)m * DM, lane);
        else rms_row_bf16(a.in[2] + (size_t)(m - MT) * DM, a.in[12], (bf16_t*)(ws + WS_HM) + (size_t)(m - MT) * DM, lane);
    }
}

constexpr int RP = 136;
constexpr int RTILE = 128 * RP * 2;
__device__ __forceinline__ bf16x8 rfrag(const LAS unsigned char* tile, int row, int ks, int fq) { return *(const LAS bf16x8*)(tile + (row * RP + 32 * ks + 8 * fq) * 2); }
__device__ __forceinline__ float ret_lg2(int h) { return log2f(1.0f - exp2f(-5.0f - (float)h)); }

template <bool TRANSPOSE> __device__ __forceinline__ void stage_rot(const bf16_t* Z, int r0, int coff, int posidx0, const float* ropeC, const float* ropeS, LAS unsigned char* dst, float scale, float lg2, bool decay) {
    const int tid = threadIdx.x, j = tid >> 2, dq = tid & 3;
    const bf16_t* src = Z + (size_t)(r0 + j) * INC + coff + 16 * dq;
    const u32x4 a0 = *(const u32x4*)(src), a1 = *(const u32x4*)(src + 8), b0 = *(const u32x4*)(src + 64), b1 = *(const u32x4*)(src + 72);
    const float* cs = ropeC + (size_t)(posidx0 + j) * 64 + 16 * dq; const float* sn = ropeS + (size_t)(posidx0 + j) * 64 + 16 * dq;
    float sc = scale; if (decay) sc *= exp2f((float)(127 - j) * lg2);
    float y1[16], y2[16];
#pragma unroll
    for (int e = 0; e < 16; ++e) { const unsigned wa = (e < 8) ? a0[(e & 7) >> 1] : a1[(e & 7) >> 1]; const unsigned wb = (e < 8) ? b0[(e & 7) >> 1] : b1[(e & 7) >> 1];
        const float x1 = (e & 1) ? bfhi(wa) : bflo(wa), x2 = (e & 1) ? bfhi(wb) : bflo(wb); const float c = cs[e], s = sn[e];
        y1[e] = (x1 * c - x2 * s) * sc; y2[e] = (x1 * s + x2 * c) * sc; }
    if (TRANSPOSE) {
        LAS bf16_t* d = (LAS bf16_t*)dst;
#pragma unroll
        for (int e = 0; e < 16; ++e) { d[(16 * dq + e) * RP + j] = (bf16_t)f2bf(y1[e]); d[(64 + 16 * dq + e) * RP + j] = (bf16_t)f2bf(y2[e]); }
    } else {
        LAS unsigned char* p = dst + (j * RP + 16 * dq) * 2;
        u32x4 w;
        w.x = pk2(y1[0], y1[1]); w.y = pk2(y1[2], y1[3]); w.z = pk2(y1[4], y1[5]); w.w = pk2(y1[6], y1[7]); *(LAS u32x4*)(p) = w;
        w.x = pk2(y1[8], y1[9]); w.y = pk2(y1[10], y1[11]); w.z = pk2(y1[12], y1[13]); w.w = pk2(y1[14], y1[15]); *(LAS u32x4*)(p + 16) = w;
        w.x = pk2(y2[0], y2[1]); w.y = pk2(y2[2], y2[3]); w.z = pk2(y2[4], y2[5]); w.w = pk2(y2[6], y2[7]); *(LAS u32x4*)(p + 128) = w;
        w.x = pk2(y2[8], y2[9]); w.y = pk2(y2[10], y2[11]); w.z = pk2(y2[12], y2[13]); w.w = pk2(y2[14], y2[15]); *(LAS u32x4*)(p + 144) = w;
    }
}
__device__ __forceinline__ void stage_vt(const bf16_t* Z, int r0, int coff, LAS unsigned char* dst) {
    const int tid = threadIdx.x, j = tid >> 2, eq = tid & 3;
    const bf16_t* src = Z + (size_t)(r0 + j) * INC + coff + 32 * eq;
    LAS bf16_t* d = (LAS bf16_t*)dst;
#pragma unroll
    for (int q = 0; q < 4; ++q) { const u32x4 v = *(const u32x4*)(src + 8 * q);
#pragma unroll
        for (int e = 0; e < 8; ++e) { const unsigned w = v[e >> 1]; d[(32 * eq + 8 * q + e) * RP + j] = (bf16_t)((e & 1) ? (w >> 16) : (w & 0xffffu)); } }
}

__device__ __forceinline__ void r1_unit(const Args& a, LAS unsigned char* lds, int unit) {
    const int tid = threadIdx.x, lane = tid & 63, w = tid >> 6, fr = lane & 15, fq = lane >> 4;
    const int bh = unit >> 4, c = unit & 15, b = bh >> 3, h = bh & 7;
    const bf16_t* Z = (const bf16_t*)(a.ws + WS_Z); const float* ropeC = (const float*)(a.ws + WS_ROPE); const float* ropeS = ropeC + 2056 * 64;
    const int r0 = b * TP + c * 128; const float lg2 = ret_lg2(h);
    LAS unsigned char* KT = lds + RTILE; LAS unsigned char* VT = lds + 2 * RTILE;
    stage_rot<true>(Z, r0, ZK + h * RD, c * 128, ropeC, ropeS, KT, KSCALE, lg2, true);
    stage_vt(Z, r0, ZV + h * RD, VT);
    __syncthreads();
    f32x4 acc[8];
#pragma unroll
    for (int t = 0; t < 8; ++t) acc[t] = (f32x4){0.f, 0.f, 0.f, 0.f};
#pragma unroll
    for (int ks = 0; ks < 4; ++ks) { const bf16x8 y = rfrag(VT, 16 * w + fr, ks, fq);
#pragma unroll
        for (int t = 0; t < 8; ++t) { const bf16x8 x = rfrag(KT, 16 * t + fr, ks, fq); acc[t] = __builtin_amdgcn_mfma_f32_16x16x32_bf16(x, y, acc[t], 0, 0, 0); } }
    float* kv = (float*)(a.ws + WS_KV) + ((size_t)unit * 128 + 16 * w + fr) * 128 + 4 * fq;
#pragma unroll
    for (int t = 0; t < 8; ++t) *(f32x4*)(kv + 16 * t) = acc[t];
    __syncthreads();
}

__device__ __forceinline__ void r2_unit(const Args& a, LAS unsigned char* lds, int bh, int c) {
    const int tid = threadIdx.x, lane = tid & 63, w = tid >> 6, fr = lane & 15, fq = lane >> 4;
    const int b = bh >> 3, h = bh & 7;
    const bf16_t* Z = (const bf16_t*)(a.ws + WS_Z); const float* ropeC = (const float*)(a.ws + WS_ROPE); const float* ropeS = ropeC + 2056 * 64;
    const int r0 = b * TP + c * 128; const float lg2 = ret_lg2(h);
    LAS unsigned char* QL = lds; LAS unsigned char* KL = lds + RTILE; LAS unsigned char* VT = lds + 2 * RTILE; LAS unsigned char* ST = lds + 3 * RTILE;
    stage_rot<false>(Z, r0, ZQ + h * RD, c * 128, ropeC, ropeS, QL, 1.0f, lg2, false);
    stage_rot<false>(Z, r0, ZK + h * RD, c * 128, ropeC, ropeS, KL, KSCALE, lg2, false);
    stage_vt(Z, r0, ZV + h * RD, VT);
    {
        const float cd = exp2f(128.0f * lg2);
        f32x4 s[8];
#pragma unroll
        for (int k = 0; k < 8; ++k) s[k] = (f32x4){0.f, 0.f, 0.f, 0.f};
        const float* kv = (const float*)(a.ws + WS_KV) + (size_t)(bh * 16) * 16384 + tid * 4;
        for (int j = 0; j < c; ++j) {
#pragma unroll
            for (int k = 0; k < 8; ++k) { const f32x4 v = *(const f32x4*)(kv + (size_t)j * 16384 + k * 2048); s[k] = s[k] * cd + v; } }
#pragma unroll
        for (int k = 0; k < 8; ++k) { const int idx = tid + 512 * k, e = idx >> 5, d4 = (idx & 31) * 4; u32x2 wv; wv.x = pk2(s[k][0], s[k][1]); wv.y = pk2(s[k][2], s[k][3]);
            *(LAS u32x2*)(ST + (e * RP + d4) * 2) = wv; }
        if (c == 15) {
            float* so = a.out + O_SRP + (size_t)bh * 16384;
#pragma unroll
            for (int k = 0; k < 8; ++k) { const f32x4 v = *(const f32x4*)(kv + (size_t)15 * 16384 + k * 2048); const f32x4 f = s[k] * cd + v;
                const int idx = tid + 512 * k, e = idx >> 5, d4 = (idx & 31) * 4;
                so[(d4 + 0) * 128 + e] = f[0]; so[(d4 + 1) * 128 + e] = f[1]; so[(d4 + 2) * 128 + e] = f[2]; so[(d4 + 3) * 128 + e] = f[3]; }
        }
    }
    __syncthreads();
    const int il = 16 * w + fr;
    bf16x8 yq[4];
#pragma unroll
    for (int ks = 0; ks < 4; ++ks) yq[ks] = rfrag(QL, il, ks, fq);
    f32x4 o[8], sc[8];
#pragma unroll
    for (int t = 0; t < 8; ++t) { o[t] = (f32x4){0.f, 0.f, 0.f, 0.f}; sc[t] = (f32x4){0.f, 0.f, 0.f, 0.f}; }
#pragma unroll
    for (int ks = 0; ks < 4; ++ks)
#pragma unroll
        for (int t = 0; t < 8; ++t) { const bf16x8 x = rfrag(ST, 16 * t + fr, ks, fq); o[t] = __builtin_amdgcn_mfma_f32_16x16x32_bf16(x, yq[ks], o[t], 0, 0, 0); }
    const float qd = exp2f((float)(il + 1) * lg2);
#pragma unroll
    for (int t = 0; t < 8; ++t) o[t] = o[t] * qd;
#pragma unroll
    for (int ks = 0; ks < 4; ++ks)
#pragma unroll
        for (int t = 0; t < 8; ++t) { const bf16x8 x = rfrag(KL, 16 * t + fr, ks, fq); sc[t] = __builtin_amdgcn_mfma_f32_16x16x32_bf16(x, yq[ks], sc[t], 0, 0, 0); }
    __syncthreads();
#pragma unroll
    for (int t = 0; t < 8; ++t) { float p[4];
#pragma unroll
        for (int r = 0; r < 4; ++r) { const int j = 16 * t + 4 * fq + r; p[r] = (j <= il) ? sc[t][r] * exp2f((float)(il - j) * lg2) : 0.f; }
        u32x2 wv; wv.x = pk2(p[0], p[1]); wv.y = pk2(p[2], p[3]); *(LAS u32x2*)(ST + (il * RP + 16 * t + 4 * fq) * 2) = wv; }
    LDS_WAIT();
#pragma unroll
    for (int ks = 0; ks < 4; ++ks) { const bf16x8 y = rfrag(ST, il, ks, fq);
#pragma unroll
        for (int t = 0; t < 8; ++t) { const bf16x8 x = rfrag(VT, 16 * t + fr, ks, fq); o[t] = __builtin_amdgcn_mfma_f32_16x16x32_bf16(x, y, o[t], 0, 0, 0); } }
    float s1 = 0.f;
#pragma unroll
    for (int t = 0; t < 8; ++t) s1 += (o[t][0] + o[t][1]) + (o[t][2] + o[t][3]);
    s1 += __shfl_xor(s1, 16); s1 += __shfl_xor(s1, 32);
    const float mu = s1 * (1.0f / 128.0f); float s2 = 0.f;
#pragma unroll
    for (int t = 0; t < 8; ++t) { o[t] = o[t] - mu; s2 += (o[t][0] * o[t][0] + o[t][1] * o[t][1]) + (o[t][2] * o[t][2] + o[t][3] * o[t][3]); }
    s2 += __shfl_xor(s2, 16); s2 += __shfl_xor(s2, 32);
    const float rstd = rsqrtf(s2 * (1.0f / 128.0f) + GN_EPS);
    const int row = r0 + il; const float* gn = a.in[10] + h * RD; const bf16_t* gz = Z + (size_t)row * INC + ZG + h * RD; bf16_t* mix = (bf16_t*)(a.ws + WS_MIX) + (size_t)row * DM + h * RD;
#pragma unroll
    for (int t = 0; t < 8; ++t) { const int e0 = 16 * t + 4 * fq; const f32x4 gg = *(const f32x4*)(gn + e0); const u32x2 gw = *(const u32x2*)(gz + e0);
        const float g0 = bflo(gw.x), g1 = bfhi(gw.x), g2 = bflo(gw.y), g3 = bfhi(gw.y);
        u32x2 wv; wv.x = pk2(silu_f(g0) * o[t][0] * rstd * gg[0], silu_f(g1) * o[t][1] * rstd * gg[1]); wv.y = pk2(silu_f(g2) * o[t][2] * rstd * gg[2], silu_f(g3) * o[t][3] * rstd * gg[3]);
        *(u32x2*)(mix + e0) = wv; }
    __syncthreads();
}

__device__ __forceinline__ void rs_unit(const Args& a, LAS unsigned char* lds, int unit) {
    const int tid = threadIdx.x, lane = tid & 63, w = tid >> 6;
    const int bs = unit >> 3, h = unit & 7; const float lg2 = ret_lg2(h);
    const bf16_t* Z = (const bf16_t*)(a.ws + WS_Z); const float* ropeC = (const float*)(a.ws + WS_ROPE); const float* ropeS = ropeC + 2056 * 64;
    const int r0 = MP + bs * TS;
    LAS float* qT = (LAS float*)lds;
    LAS float* kT = qT + 1024;
    LAS float* vL = kT + 1024;
    LAS float* scL = vL + 1024;
    LAS float* red = scL + 64;
    {
        const int which = tid >> 8, i = (tid >> 5) & 7, d = 2 * (tid & 31);
        const bf16_t* src = Z + (size_t)(r0 + i) * INC + (which ? ZK : ZQ) + h * RD + d;
        const unsigned wa = *(const unsigned*)src, wb = *(const unsigned*)(src + 64);
        const float* cs = ropeC + (size_t)(2048 + i) * 64 + d; const float* sn = ropeS + (size_t)(2048 + i) * 64 + d;
        const float sc = which ? KSCALE * exp2f((float)(7 - i) * lg2) : 1.0f;
        LAS float* dst = which ? kT : qT;
        { const float x1 = bflo(wa), x2 = bflo(wb), c = cs[0], s = sn[0]; dst[d * 8 + i] = (x1 * c - x2 * s) * sc; dst[(d + 64) * 8 + i] = (x1 * s + x2 * c) * sc; }
        { const float x1 = bfhi(wa), x2 = bfhi(wb), c = cs[1], s = sn[1]; dst[(d + 1) * 8 + i] = (x1 * c - x2 * s) * sc; dst[(d + 65) * 8 + i] = (x1 * s + x2 * c) * sc; }
        const int j = tid >> 6, e = 2 * (tid & 63); const unsigned wv = *(const unsigned*)(Z + (size_t)(r0 + j) * INC + ZV + h * RD + e);
        vL[j * 128 + e] = bflo(wv); vL[j * 128 + e + 1] = bfhi(wv);
    }
    __syncthreads();
    {
        const int pr = tid >> 3, i = pr >> 3, j = pr & 7, part = tid & 7; float s = 0.f;
#pragma unroll
        for (int d = 0; d < 16; ++d) s += qT[(part * 16 + d) * 8 + i] * kT[(part * 16 + d) * 8 + j];
        s += __shfl_xor(s, 1); s += __shfl_xor(s, 2); s += __shfl_xor(s, 4);
        if (part == 0) scL[i * 8 + j] = (j <= i) ? s * exp2f((float)(i - 7) * lg2) : 0.f;
    }
    {
        const int e = tid & 127, dg = tid >> 7; const float cd = exp2f(8.0f * lg2);
        float vr[8], cr[8];
#pragma unroll
        for (int j = 0; j < 8; ++j) { vr[j] = vL[j * 128 + e]; cr[j] = 0.f; }
        const float* s0 = a.in[3] + ((size_t)unit * 128 + dg * 32) * 128 + e; float* so = a.out + O_SRS + ((size_t)unit * 128 + dg * 32) * 128 + e;
#pragma unroll 8
        for (int d = 0; d < 32; ++d) { const float s = s0[d * 128]; const int dd = dg * 32 + d;
            const f32x4 q0 = *(const LAS f32x4*)(qT + dd * 8), q1 = *(const LAS f32x4*)(qT + dd * 8 + 4), k0 = *(const LAS f32x4*)(kT + dd * 8), k1 = *(const LAS f32x4*)(kT + dd * 8 + 4);
            float sn = s * cd;
#pragma unroll
            for (int i = 0; i < 4; ++i) { cr[i] += q0[i] * s; cr[i + 4] += q1[i] * s; sn += k0[i] * vr[i]; sn += k1[i] * vr[i + 4]; }
            so[d * 128] = sn; }
#pragma unroll
        for (int i = 0; i < 8; ++i) red[(dg * 8 + i) * 128 + e] = cr[i];
    }
    __syncthreads();
    {
        const int i = w; const float qd = exp2f((float)(i + 1) * lg2); float o[2];
#pragma unroll
        for (int q = 0; q < 2; ++q) { const int e = lane + 64 * q; float v = (red[(0 * 8 + i) * 128 + e] + red[(1 * 8 + i) * 128 + e]) + (red[(2 * 8 + i) * 128 + e] + red[(3 * 8 + i) * 128 + e]); v *= qd;
#pragma unroll
            for (int j = 0; j < 8; ++j) v += scL[i * 8 + j] * vL[j * 128 + e];
            o[q] = v; }
        const float mu = wave_sum(o[0] + o[1]) * (1.0f / 128.0f); o[0] -= mu; o[1] -= mu;
        const float rstd = rsqrtf(wave_sum(o[0] * o[0] + o[1] * o[1]) * (1.0f / 128.0f) + GN_EPS);
        const int row = r0 + i;
#pragma unroll
        for (int q = 0; q < 2; ++q) { const int e = lane + 64 * q; const float g = bf2f(Z[(size_t)row * INC + ZG + h * RD + e]);
            ((bf16_t*)(a.ws + WS_MIX))[(size_t)row * DM + h * RD + e] = (bf16_t)f2bf(silu_f(g) * o[q] * rstd * a.in[10][h * RD + e]); }
    }
    __syncthreads();
}

__device__ __forceinline__ void conv_row(const Args& a, int row) {
    const int tid = threadIdx.x, c = 2 * tid;
    const bf16_t* Z = (const bf16_t*)(a.ws + WS_Z);
    int t, T; const float* cbuf = nullptr; float* sout;
    if (row < MP) { t = row & (TP - 1); T = TP; sout = a.out + O_SCP + (size_t)(row >> 11) * 2048; }
    else { const int r = row - MP; t = r & 7; T = TS; cbuf = a.in[4] + (size_t)(r >> 3) * 2048; sout = a.out + O_SCS + (size_t)(r >> 3) * 2048; }
    float u[3][2];
#pragma unroll
    for (int k = 0; k < 3; ++k) { const int tt = t - 2 + k;
        if (tt >= 0) { const bf16_t* zr = Z + (size_t)(row - 2 + k) * INC; const unsigned wc = *(const unsigned*)(zr + ZCG + c), wh = *(const unsigned*)(zr + ZHIN + c); u[k][0] = bflo(wc) * bflo(wh); u[k][1] = bfhi(wc) * bfhi(wh); }
        else if (cbuf) { const f32x2 v = *(const f32x2*)(cbuf + (tt + 2) * 1024 + c); u[k][0] = v[0]; u[k][1] = v[1]; }
        else { u[k][0] = 0.f; u[k][1] = 0.f; } }
    const float* cw = a.in[9];
    const f32x2 w0 = *(const f32x2*)(cw + c), w1 = *(const f32x2*)(cw + 1024 + c), w2 = *(const f32x2*)(cw + 2048 + c);
    const unsigned wb = *(const unsigned*)(Z + (size_t)row * INC + ZBG + c);
    const float o0 = bflo(wb) * (w0[0] * u[0][0] + w1[0] * u[1][0] + w2[0] * u[2][0]), o1 = bfhi(wb) * (w0[1] * u[0][1] + w1[1] * u[1][1] + w2[1] * u[2][1]);
    *(unsigned*)((bf16_t*)(a.ws + WS_MIX) + (size_t)row * DM + 1024 + c) = pk2(o0, o1);
    if (t >= T - 2) { f32x2 v; v[0] = u[2][0]; v[1] = u[2][1]; *(f32x2*)(sout + (t - (T - 2)) * 1024 + c) = v; }
}

__device__ __forceinline__ void sa_unit(const Args& a, LAS unsigned char* lds, int unit) {
    const int tid = threadIdx.x, lane = tid & 63, w = tid >> 6;
    const int bs = unit >> 2, h = unit & 3;
    LAS float* SL = (LAS float*)lds;
    LAS float* PT = SL + 2048;
    LAS float* OR = PT + 2048;
    const bf16_t* Qb = (const bf16_t*)(a.ws + WS_Q) + (size_t)(MP + bs * TS) * DM + h * XD;
    float q[8][8];
#pragma unroll
    for (int r = 0; r < 8; ++r) { const u32x2 w0 = *(const u32x2*)(Qb + (size_t)r * DM + 4 * lane), w1 = *(const u32x2*)(Qb + (size_t)r * DM + 256 + 4 * lane);
        q[r][0] = bflo(w0.x); q[r][1] = bfhi(w0.x); q[r][2] = bflo(w0.y); q[r][3] = bfhi(w0.y); q[r][4] = bflo(w1.x); q[r][5] = bfhi(w1.x); q[r][6] = bflo(w1.y); q[r][7] = bfhi(w1.y); }
    const float* Kb = a.in[5] + ((size_t)(bs * NMEM) * XH + h) * XD;
    const int rsel = 4 * (lane & 1) + 2 * ((lane >> 1) & 1) + ((lane >> 2) & 1);
    for (int kk = 0; kk < 32; kk += 4) {
        f32x4 k0[4], k1[4];
#pragma unroll
        for (int u = 0; u < 4; ++u) { const float* p = Kb + (size_t)(32 * w + kk + u) * (XH * XD); k0[u] = *(const f32x4*)(p + 4 * lane); k1[u] = *(const f32x4*)(p + 256 + 4 * lane); }
#pragma unroll
        for (int u = 0; u < 4; ++u) { float p8[8];
#pragma unroll
            for (int r = 0; r < 8; ++r) p8[r] = (q[r][0] * k0[u][0] + q[r][1] * k0[u][1]) + (q[r][2] * k0[u][2] + q[r][3] * k0[u][3]) + (q[r][4] * k1[u][0] + q[r][5] * k1[u][1]) + (q[r][6] * k1[u][2] + q[r][7] * k1[u][3]);
            float q4[4], q2[2], q1;
#pragma unroll
            for (int i = 0; i < 4; ++i) { const float send = (lane & 1) ? p8[i] : p8[i + 4], keep = (lane & 1) ? p8[i + 4] : p8[i]; q4[i] = keep + __shfl_xor(send, 1); }
#pragma unroll
            for (int i = 0; i < 2; ++i) { const float send = (lane & 2) ? q4[i] : q4[i + 2], keep = (lane & 2) ? q4[i + 2] : q4[i]; q2[i] = keep + __shfl_xor(send, 2); }
            { const float send = (lane & 4) ? q2[0] : q2[1], keep = (lane & 4) ? q2[1] : q2[0]; q1 = keep + __shfl_xor(send, 4); }
            q1 += __shfl_xor(q1, 8); q1 += __shfl_xor(q1, 16); q1 += __shfl_xor(q1, 32);
            if (lane < 8) SL[rsel * 256 + 32 * w + kk + u] = q1; }
    }
    __syncthreads();
    {
        float v[4]; float mx = -3.0e38f;
#pragma unroll
        for (int i = 0; i < 4; ++i) { v[i] = SL[w * 256 + lane + 64 * i]; mx = fmaxf(mx, v[i]); }
        mx = wave_max(mx); float s = 0.f;
#pragma unroll
        for (int i = 0; i < 4; ++i) { v[i] = __builtin_amdgcn_exp2f(v[i] - mx); s += v[i]; }
        const float inv = 1.0f / wave_sum(s);
#pragma unroll
        for (int i = 0; i < 4; ++i) PT[(lane + 64 * i) * 8 + w] = v[i] * inv;
    }
    __syncthreads();
    {
        const int g = tid >> 7, c = tid & 127;
        const float* Vb = a.in[6] + ((size_t)(bs * NMEM + g * 64) * XH + h) * XD + 4 * c;
        f32x4 acc[8];
#pragma unroll
        for (int r = 0; r < 8; ++r) acc[r] = (f32x4){0.f, 0.f, 0.f, 0.f};
        for (int k8 = 0; k8 < 64; k8 += 8) { f32x4 v[8];
#pragma unroll
            for (int u = 0; u < 8; ++u) v[u] = *(const f32x4*)(Vb + (size_t)(k8 + u) * (XH * XD));
#pragma unroll
            for (int u = 0; u < 8; ++u) { const int key = g * 64 + k8 + u; const f32x4 p0 = *(const LAS f32x4*)(PT + key * 8), p1 = *(const LAS f32x4*)(PT + key * 8 + 4);
#pragma unroll
                for (int r = 0; r < 4; ++r) { acc[r] = acc[r] + v[u] * p0[r]; acc[r + 4] = acc[r + 4] + v[u] * p1[r]; } } }
#pragma unroll
        for (int r = 0; r < 8; ++r) *(LAS f32x4*)(OR + (g * 8 + r) * 512 + 4 * c) = acc[r];
    }
    __syncthreads();
    {
        f32x4 s0 = (f32x4){0.f, 0.f, 0.f, 0.f}, s1 = s0;
#pragma unroll
        for (int g = 0; g < 4; ++g) { s0 = s0 + *(const LAS f32x4*)(OR + (g * 8 + w) * 512 + 8 * lane); s1 = s1 + *(const LAS f32x4*)(OR + (g * 8 + w) * 512 + 8 * lane + 4); }
        u32x4 o; o.x = pk2(s0[0], s0[1]); o.y = pk2(s0[2], s0[3]); o.z = pk2(s1[0], s1[1]); o.w = pk2(s1[2], s1[3]);
        *(u32x4*)((bf16_t*)(a.ws + WS_AO) + (size_t)(MP + bs * TS + w) * DM + h * XD + 8 * lane) = o;
    }
    __syncthreads();
}

__global__ void __launch_bounds__(NTHR, 2) fwd_kernel(Args a) {
    extern __shared__ __attribute__((aligned(16))) unsigned char lds_raw[];
    LAS unsigned char* lds = (LAS unsigned char*)lds_raw;
    cg::grid_group grid = cg::this_grid();
    const int tid = threadIdx.x, lane = tid & 63, wave = tid >> 6, G = gridDim.x, bid = blockIdx.x;
    unsigned char* ws = a.ws;
    float* ctlf = (float*)(ws + WS_CTL);
    const int lo = a.lo, hi = a.hi;
#ifndef ONLY
#define ONLY -1
#endif
#define IN(k) ((ONLY < 0 || ONLY == (k)) && lo <= (k) && (k) < hi)
#define SEAM(k) do { if (a.coop && IN(k) && IN((k) + 1)) grid.sync(); } while (0)

    if (IN(0)) { p0_prologue(a, lds); }
    SEAM(0);
    if (IN(1)) {
        { pg8::Gemm g{(const bf16_t*)(ws + WS_H1), (const bf16_t*)(ws + WS_WIN), DM, DM, DM}; pg8::StaticOrder S; S.init(MT, INC, G, bid);
          pg8::EpiBf16 E{(bf16_t*)(ws + WS_Z), INC, nullptr, 1.0f}; pg8::gemm_phase<pg8::EpiBf16, pg8::StaticOrder, true>(lds, g, S, E); }
        { pg8::Gemm g{(const bf16_t*)(ws + WS_HM), (const bf16_t*)(ws + WS_WMKV), DM, DM, DM}; pg8::StaticOrder S; S.init(BP * NMEM, 2 * DM, G, G - 1 - bid);
          pg8::EpiMemKV E{a.out + O_MK, a.out + O_MV, (bf16_t*)(ws + WS_MKB), (bf16_t*)(ws + WS_VT)}; pg8::gemm_phase<pg8::EpiMemKV, pg8::StaticOrder, true>(lds, g, S, E); }
    }
    SEAM(1);
    if (IN(2)) {
        for (int u = bid; u < BP * RH * 16; u += G) r1_unit(a, lds, u);
        for (int u = bid; u < BS * RH; u += G) rs_unit(a, lds, u);
        for (int r = bid; r < MT; r += G) conv_row(a, r);
    }
    SEAM(2);
    if (IN(3)) {
        for (int u = bid; u < BP * RH * 16; u += G) { const int v = u & 255, bh = v >> 3, c = (u < 256) ? (v & 7) : 15 - (v & 7); r2_unit(a, lds, bh, c); }
    }
    SEAM(3);
    if (IN(4)) {
        pg8::Gemm g{(const bf16_t*)(ws + WS_MIX), (const bf16_t*)(ws + WS_WMO), DM, DM, DM}; pg8::StaticOrder S; S.init(MT, DM, G, bid);
        pg8::EpiRes E{a.in[0], a.in[1], (float*)(ws + WS_X), (bf16_t*)(ws + WS_X1B), ctlf + CW_SSQ1}; pg8::gemm_phase<pg8::EpiRes, pg8::StaticOrder, true>(lds, g, S, E);
    }
    SEAM(4);
    if (IN(5)) {
        pg8::Gemm g{(const bf16_t*)(ws + WS_X1B), (const bf16_t*)(ws + WS_WXQ), DM, DM, DM}; pg8::StaticOrder S; S.init(MT, DM, G, bid);
        pg8::EpiBf16 E{(bf16_t*)(ws + WS_Q), DM, ctlf + CW_SSQ1, QSCALE}; pg8::gemm_phase<pg8::EpiBf16, pg8::StaticOrder, true>(lds, g, S, E);
    }
    SEAM(5);
    if (IN(6)) {
#ifndef NO_PA
        if (bid < BP * XH * 8) { const int u = bid, bh = u >> 3, rb = u & 7, b = bh >> 2, h = bh & 3;
#ifndef NO_PA1
            { pg8::Gemm g{(const bf16_t*)(ws + WS_Q) + h * XD, (const bf16_t*)(ws + WS_MKB) + h * XD, DM, DM, XD}; pg8::ListOrder S{b * 8 + rb, b, 1};
              pg8::EpiSoftmax E{(bf16_t*)(ws + WS_P), h}; pg8::gemm_phase<pg8::EpiSoftmax, pg8::ListOrder, false>(lds, g, S, E); }
#endif
            __threadfence(); __syncthreads();
            { pg8::Gemm g{(const bf16_t*)(ws + WS_P), (const bf16_t*)(ws + WS_VT), NMEM, NMEM, NMEM}; pg8::ListOrder S{bh * 8 + rb, bh * 2, 2};
              pg8::EpiPV E{(bf16_t*)(ws + WS_AO)}; pg8::gemm_phase<pg8::EpiPV, pg8::ListOrder, true>(lds, g, S, E); }
            __syncthreads();
        }
#endif
#ifndef NO_SA
        LAS unsigned* nxt = (LAS unsigned*)(lds + 140000);
        for (;;) { __syncthreads(); if (tid == 0) *nxt = atomicAdd((unsigned*)(ws + WS_CTL) + CW_ATT, 1u); __syncthreads(); const unsigned u = *nxt; if (u >= (unsigned)(BS * XH)) break; sa_unit(a, lds, (int)u); }
#endif
    }
    SEAM(6);
    if (IN(7)) {
        pg8::Gemm g{(const bf16_t*)(ws + WS_AO), (const bf16_t*)(ws + WS_WXO), DM, DM, DM}; pg8::StaticOrder S; S.init(MT, DM, G, bid);
        pg8::EpiRes E{(const float*)(ws + WS_X), (const float*)(ws + WS_X) + (size_t)MP * DM, (float*)(ws + WS_X), (bf16_t*)(ws + WS_X2B), ctlf + CW_SSQ2}; pg8::gemm_phase<pg8::EpiRes, pg8::StaticOrder, true>(lds, g, S, E);
    }
    SEAM(7);
    if (IN(8)) {
        pg8::Gemm g{(const bf16_t*)(ws + WS_X2B), (const bf16_t*)(ws + WS_WGU), DM, DM, DM}; pg8::StaticOrder S; S.init(MT, 2 * DFF, G, bid);
        pg8::EpiSwiglu E{(bf16_t*)(ws + WS_HFF), ctlf + CW_SSQ2}; pg8::gemm_phase<pg8::EpiSwiglu, pg8::StaticOrder, true>(lds, g, S, E);
    }
    SEAM(8);
    if (IN(9)) {
        pg8::Gemm g{(const bf16_t*)(ws + WS_HFF), (const bf16_t*)(ws + WS_WD), DFF, DFF, DFF}; pg8::StaticOrder S; S.init(MT, DM, G, bid);
        pg8::EpiRes E{(const float*)(ws + WS_X), (const float*)(ws + WS_X) + (size_t)MP * DM, a.out + O_Y, nullptr, ctlf + CW_SSQ3}; pg8::gemm_phase<pg8::EpiRes, pg8::StaticOrder, true>(lds, g, S, E);
    }
    SEAM(9);
    if (IN(10)) {
        const float* ssq = ctlf + CW_SSQ3; const float* fg = a.in[22];
        for (int m = bid * 8 + wave; m < MT; m += G * 8) { const float rstd = rsqrtf(ssq[m] * (1.0f / DM) + RMS_EPS); f32x4* y = (f32x4*)(a.out + O_Y + (size_t)m * DM) + lane;
#pragma unroll
            for (int j = 0; j < 8; ++j) { const f32x4 gg = ((const f32x4*)fg)[lane + 64 * j]; f32x4 v = y[64 * j]; v = v * rstd * gg; y[64 * j] = v; } }
    }
#undef IN
#undef SEAM
}

constexpr int NPHASE = 11;
#ifndef MK_COOP
#define MK_COOP 1
#endif
extern "C" void kernel_launch(void* const* d_in, const int* in_sizes, int n_in, void* d_out, int out_size, void* d_ws, size_t ws_size, hipStream_t stream) {
    static int grid = 0;
    if (grid == 0) {
        if (n_in != 23 || ws_size < WS_END) { fprintf(stderr, "kernel_launch: unexpected inputs (n_in %d, ws %zu < %zu)\n", n_in, ws_size, (size_t)WS_END); grid = -1; return; }
        int dev = 0, cus = 0, per_cu = 0;
        (void)hipGetDevice(&dev); (void)hipDeviceGetAttribute(&cus, hipDeviceAttributeMultiprocessorCount, dev);
        (void)hipFuncSetAttribute((const void*)fwd_kernel, hipFuncAttributeMaxDynamicSharedMemorySize, LDS_BYTES);
        (void)hipOccupancyMaxActiveBlocksPerMultiprocessor(&per_cu, (const void*)fwd_kernel, NTHR, LDS_BYTES);
        if (per_cu < 1) per_cu = 1;
        grid = cus * per_cu;
        if (grid < 128) { fprintf(stderr, "kernel_launch: grid %d < 128 workgroups: unsupported device\n", grid); grid = -1; return; }
        (void)hipGetLastError();
    }
    if (grid < 0) return;
    Args a{};
    for (int i = 0; i < 23; ++i) a.in[i] = (const float*)d_in[i];
    a.out = (float*)d_out; a.ws = (unsigned char*)d_ws;
#if MK_COOP
    a.lo = 0; a.hi = NPHASE; a.coop = 1;
    void* args[] = {&a};
    hipError_t e = hipLaunchCooperativeKernel((const void*)fwd_kernel, dim3(grid), dim3(NTHR), args, LDS_BYTES, stream);
    if (e != hipSuccess) fprintf(stderr, "cooperative launch failed: %s (grid %d)\n", hipGetErrorString(e), grid);
#else
    for (int p = 0; p < NPHASE; ++p) { a.lo = p; a.hi = p + 1; a.coop = 0; hipLaunchKernelGGL(fwd_kernel, dim3(grid), dim3(NTHR), LDS_BYTES, stream, a); }
#endif
}
```

```cpp
#include <hip/hip_runtime.h>
#include <hip/hip_cooperative_groups.h>
#include <cstdio>
#include <cstdint>
namespace cg = cooperative_groups;

#define LAS __attribute__((address_space(3)))
typedef unsigned short bf16_t;
typedef short bf16x8 __attribute__((ext_vector_type(8)));
typedef float f32x4 __attribute__((ext_vector_type(4)));
typedef float f32x2 __attribute__((ext_vector_type(2)));
typedef unsigned u32x4 __attribute__((ext_vector_type(4)));
typedef unsigned u32x2 __attribute__((ext_vector_type(2)));

constexpr int DM = 2048, TP = 2048, BP = 4, MP = BP * TP, BS = 128, TS = 8, MS = BS * TS, MT = MP + MS;
constexpr int INC = 7168, RH = 8, RD = 128, NMEM = 256, XH = 4, XD = 512, DFF = 5632, PAST = 16384;
constexpr int ZQ = 0, ZK = 1024, ZV = 2048, ZG = 3072, ZBG = 4096, ZCG = 5120, ZHIN = 6144;
constexpr float RMS_EPS = 1e-6f, GN_EPS = 1e-5f;
constexpr float QSCALE = 0.04419417382415922f * 1.4426950408889634f;
constexpr float KSCALE = 0.08838834764831845f;
constexpr size_t O_Y = 0, O_SRP = (size_t)MT * DM, O_SRS = O_SRP + (size_t)BP * RH * RD * RD, O_SCP = O_SRS + (size_t)BS * RH * RD * RD,
                 O_SCS = O_SCP + (size_t)BP * 2 * 1024, O_MK = O_SCS + (size_t)BS * 2 * 1024, O_MV = O_MK + (size_t)BP * NMEM * DM;
constexpr size_t MiB = 1u << 20;
constexpr size_t WS_CTL = 0, WS_ROPE = 1 * MiB, WS_WIN = 4 * MiB, WS_WMO = WS_WIN + 28 * MiB, WS_WXQ = WS_WMO + 8 * MiB, WS_WXO = WS_WXQ + 8 * MiB,
                 WS_WMKV = WS_WXO + 8 * MiB, WS_WGU = WS_WMKV + 16 * MiB, WS_WD = WS_WGU + 44 * MiB, WS_H1 = WS_WD + 22 * MiB, WS_HM = WS_H1 + 36 * MiB,
                 WS_Z = WS_HM + 4 * MiB, WS_MIX = WS_Z + 126 * MiB, WS_X = WS_MIX + 36 * MiB, WS_X1B = WS_X + 72 * MiB, WS_Q = WS_X1B + 36 * MiB,
                 WS_P = WS_Q + 36 * MiB, WS_AO = WS_P + 16 * MiB, WS_X2B = WS_AO + 36 * MiB, WS_HFF = WS_X2B + 36 * MiB, WS_KV = WS_HFF + 99 * MiB,
                 WS_MKB = WS_KV + 32 * MiB, WS_VT = WS_MKB + 4 * MiB, WS_END = WS_VT + 4 * MiB;
constexpr int CW_SSQ1 = 0, CW_SSQ2 = 16384, CW_SSQ3 = 32768, CW_ATT = 49152, CW_N = 49152 + 64, CW_BAR = 65536;
constexpr size_t CTL_ZERO_BYTES = 512 * 1024;
constexpr int LDS_BYTES = 147456;
constexpr int NTHR = 512;

__device__ __forceinline__ unsigned f2bf(float f) { unsigned u = __builtin_bit_cast(unsigned, f); return (u + 0x7fffu + ((u >> 16) & 1u)) >> 16; }
__device__ __forceinline__ float bf2f(unsigned short h) { return __builtin_bit_cast(float, (unsigned)h << 16); }
typedef __bf16 bf16x2_t __attribute__((ext_vector_type(2)));
__device__ __forceinline__ unsigned pk2(float lo, float hi) { const f32x2 v = {lo, hi}; const bf16x2_t b = __builtin_convertvector(v, bf16x2_t); return __builtin_bit_cast(unsigned, b); }
__device__ __forceinline__ float bflo(unsigned w) { return __builtin_bit_cast(float, w << 16); }
__device__ __forceinline__ float bfhi(unsigned w) { return __builtin_bit_cast(float, w & 0xffff0000u); }
__device__ __forceinline__ float wave_sum(float v) {
#pragma unroll
    for (int o = 1; o < 64; o <<= 1) v += __shfl_xor(v, o);
    return v;
}
__device__ __forceinline__ float wave_max(float v) {
#pragma unroll
    for (int o = 1; o < 64; o <<= 1) v = fmaxf(v, __shfl_xor(v, o));
    return v;
}
__device__ __forceinline__ float silu_f(float x) { return x * __builtin_amdgcn_rcpf(1.0f + __builtin_amdgcn_exp2f(-1.4426950408889634f * x)); }
#define LDS_WAIT() asm volatile("s_waitcnt lgkmcnt(0)" ::: "memory")

namespace pg8 {
constexpr int BM = 256, BK = 64, HALF = 128, HTB = HALF * BK * 2, STAGE_BYTES = 8 * HTB, NXCD = 8, WGM = 8;
__host__ __device__ __forceinline__ int lds_byte(int r, int c) { const int st = (r >> 4) * 2 + (c >> 5), rr = r & 15, cc = c & 31, ob = rr * 64 + cc * 2; return st * 1024 + (ob ^ (((ob >> 9) & 1) << 5)); }
__host__ __device__ __forceinline__ void stage_rc(int b, int& R, int& C) { const int st = b / 1024, sb = b % 1024, swz = sb ^ (((sb >> 9) & 1) << 5); R = (st >> 1) * 16 + swz / 64; C = (st & 1) * 32 + (swz % 64) / 2; }
__host__ __device__ __forceinline__ int perm32(int rho) { const int n = rho >> 4, i = rho & 15; return 8 * (i >> 2) + 4 * n + (i & 3); }

struct Unit { int pm, pn; };
struct Gemm { const bf16_t* A; const bf16_t* Bt; int lda, ldb, K; };

struct StaticOrder {
    int nM, nN, nwg, G, c;
    __device__ void init(int M, int N, int G_, int c_) { nM = M / BM; nN = N / BM; nwg = nM * nN; G = G_; c = c_; }
    __device__ bool next(int i, Unit& u) const {
        const long L = (long)i * G + c; if (L >= nwg) return false;
        int wgid = (int)L; { const int q = nwg / NXCD, r = nwg % NXCD, xcd = wgid % NXCD, off = wgid / NXCD; wgid = (xcd < r ? xcd * (q + 1) : r * (q + 1) + (xcd - r) * q) + off; }
        const int nig = WGM * nN, gid = wgid / nig, fm = gid * WGM, gsz = (nM - fm) < WGM ? (nM - fm) : WGM;
        u.pm = fm + ((wgid % nig) % gsz); u.pn = (wgid % nig) / gsz; return true;
    }
};
struct ListOrder {
    int pm, pn0, n;
    __device__ bool next(int i, Unit& u) const { if (i >= n) return false; u.pm = pm; u.pn = pn0 + i; return true; }
};

template <class Epi, class Sched, bool ALIGN_EPI>
__device__ __forceinline__ void gemm_phase(LAS unsigned char* lds, const Gemm g, const Sched& S, const Epi& E) {
    const int tid = threadIdx.x, wid = __builtin_amdgcn_readfirstlane(tid >> 6), lane = tid & 63, wr = wid >> 2, wc = wid & 3, fr = lane & 15, fq = lane >> 4;
    int Kop = g.K; asm volatile("" : "+s"(Kop));
    const int K = Kop, nt = K / BK;
    unsigned voffA[2], voffB[2];
#pragma unroll
    for (int i = 0; i < 2; ++i) { int R, C; stage_rc(tid * 16 + i * 8192, R, C); const int Rb = Epi::PERM ? ((R & ~31) + perm32(R & 31)) : R;
        voffA[i] = (unsigned)(R * g.lda + C) * 2u; voffB[i] = (unsigned)(Rb * g.ldb + C) * 2u; }
    const size_t kstep = (size_t)(BK * 2);
    const size_t hstepA = (size_t)HALF * g.lda * 2, hstepB = (size_t)HALF * g.ldb * 2;
    const size_t tstepA = 2 * hstepA, tstepB = 2 * hstepB;
    const unsigned ldsw = (unsigned)wid * 1024u;
    const int aoff = lds_byte(wr * 64 + fr, fq * 8), boff = lds_byte(wc * 32 + fr, fq * 8);
#define PG8_SA(b, h) (((b) * 2 + (h)) * HTB)
#define PG8_SB(b, h) ((4 + (b) * 2 + (h)) * HTB)
#define PG8_STAGE(bufoff, gbase, voff) do { _Pragma("unroll") for (int _i = 0; _i < 2; ++_i) \
        __builtin_amdgcn_global_load_lds((const unsigned*)((const char*)(gbase) + (voff)[_i]), (LAS unsigned*)(lds + (bufoff) + ldsw + _i * 8192), 16, 0, 0); } while (0)
#define PG8_LDA(dst, b, h) do { _Pragma("unroll") for (int m = 0; m < 4; ++m) _Pragma("unroll") for (int k = 0; k < 2; ++k) dst[m][k] = *(const LAS bf16x8*)(lds + PG8_SA(b, h) + aoff + m * 2048 + k * 1024); } while (0)
#define PG8_LDB(dst, b, h) do { _Pragma("unroll") for (int n = 0; n < 2; ++n) _Pragma("unroll") for (int k = 0; k < 2; ++k) dst[n][k] = *(const LAS bf16x8*)(lds + PG8_SB(b, h) + boff + n * 2048 + k * 1024); } while (0)
#define PG8_MMA(ai, bj, At, Bt) do { __builtin_amdgcn_s_setprio(1); _Pragma("unroll") for (int m = 0; m < 4; ++m) _Pragma("unroll") for (int n = 0; n < 2; ++n) _Pragma("unroll") for (int k = 0; k < 2; ++k) \
        acc[ai][bj][m][n] = __builtin_amdgcn_mfma_f32_16x16x32_bf16(Bt[n][k], At[m][k], acc[ai][bj][m][n], 0, 0, 0); __builtin_amdgcn_s_setprio(0); } while (0)
#define PG8_WAIT_V(n) asm volatile("s_waitcnt vmcnt(" #n ")" ::: "memory")
#define PG8_WAIT_L(n) asm volatile("s_waitcnt lgkmcnt(" #n ")" ::: "memory")
#define PG8_BAR __builtin_amdgcn_s_barrier()
#define PG8_SCHED __builtin_amdgcn_sched_barrier(0)
    Unit cur, nxt; int ui = 0;
    if (!S.next(0, cur)) return;
    f32x4 acc[2][2][4][2];
#pragma unroll
    for (int a = 0; a < 2; ++a)
#pragma unroll
        for (int b = 0; b < 2; ++b)
#pragma unroll
            for (int m = 0; m < 4; ++m)
#pragma unroll
                for (int n = 0; n < 2; ++n) acc[a][b][m][n] = (f32x4){0.f, 0.f, 0.f, 0.f};
    bf16x8 At[4][2], B0[2][2], B1[2][2];
    const char* cA = (const char*)g.A + (size_t)cur.pm * tstepA; const char* cB = (const char*)g.Bt + (size_t)cur.pn * tstepB;
    PG8_STAGE(PG8_SB(0, 0), cB, voffB); PG8_STAGE(PG8_SB(0, 1), cB + hstepB, voffB); PG8_STAGE(PG8_SA(0, 0), cA, voffA); PG8_STAGE(PG8_SA(0, 1), cA + hstepA, voffA);
    if (wr == 1) PG8_BAR;
    PG8_WAIT_V(2); PG8_BAR;
    PG8_STAGE(PG8_SB(1, 0), cB + kstep, voffB); PG8_STAGE(PG8_SA(1, 0), cA + kstep, voffA); PG8_STAGE(PG8_SB(1, 1), cB + hstepB + kstep, voffB);
    PG8_WAIT_V(6); PG8_BAR;
    for (;;) {
        const bool has_next = S.next(ui + 1, nxt);
        const char* nA = has_next ? (const char*)g.A + (size_t)nxt.pm * tstepA : cA; const char* nB = has_next ? (const char*)g.Bt + (size_t)nxt.pn * tstepB : cB;
        for (int t = 0; t < nt; t += 2) {
            const bool last = (t == nt - 2);
            const char* a1 = cA + (size_t)(t + 1) * kstep;
            const char* a2 = last ? nA : cA + (size_t)(t + 2) * kstep; const char* b2 = last ? nB : cB + (size_t)(t + 2) * kstep;
            const char* a3 = a2 + kstep; const char* b3 = b2 + kstep;
            PG8_LDB(B0, 0, 0); PG8_LDB(B1, 0, 1); PG8_SCHED; PG8_LDA(At, 0, 0); PG8_STAGE(PG8_SA(1, 1), a1 + hstepA, voffA);
            PG8_WAIT_V(8); PG8_WAIT_L(0); PG8_BAR; PG8_MMA(0, 0, At, B0); PG8_MMA(0, 1, At, B1); PG8_BAR; PG8_SCHED;
            PG8_LDA(At, 0, 1); PG8_STAGE(PG8_SB(0, 0), b2, voffB); PG8_STAGE(PG8_SB(0, 1), b2 + hstepB, voffB); PG8_STAGE(PG8_SA(0, 0), a2, voffA);
            PG8_WAIT_V(8); PG8_WAIT_L(0); PG8_BAR; PG8_MMA(1, 0, At, B0); PG8_MMA(1, 1, At, B1); PG8_BAR; PG8_SCHED;
            PG8_LDB(B0, 1, 0); PG8_LDB(B1, 1, 1); PG8_SCHED; PG8_LDA(At, 1, 0); PG8_STAGE(PG8_SA(0, 1), a2 + hstepA, voffA);
            PG8_WAIT_V(8); PG8_WAIT_L(0); PG8_BAR; PG8_MMA(0, 0, At, B0); PG8_MMA(0, 1, At, B1); PG8_BAR; PG8_SCHED;
            PG8_LDA(At, 1, 1); PG8_STAGE(PG8_SB(1, 0), b3, voffB); PG8_STAGE(PG8_SB(1, 1), b3 + hstepB, voffB); PG8_STAGE(PG8_SA(1, 0), a3, voffA);
            PG8_WAIT_V(8); PG8_WAIT_L(0); PG8_BAR; PG8_MMA(1, 0, At, B0); PG8_MMA(1, 1, At, B1); PG8_BAR; PG8_SCHED;
        }
        if constexpr (ALIGN_EPI) { if (wr == 0) PG8_BAR; }
        if constexpr (!Epi::AFTER_DRAIN) { E(acc, cur, wr, wc, fr, fq); }
        if (!has_next) break;
#pragma unroll
        for (int a = 0; a < 2; ++a)
#pragma unroll
            for (int b = 0; b < 2; ++b)
#pragma unroll
                for (int m = 0; m < 4; ++m)
#pragma unroll
                    for (int n = 0; n < 2; ++n) acc[a][b][m][n] = (f32x4){0.f, 0.f, 0.f, 0.f};
        cur = nxt; cA = nA; cB = nB; ++ui;
        if constexpr (ALIGN_EPI) { if (wr == 1) PG8_BAR; }
    }
    PG8_WAIT_V(0);
    if constexpr (!ALIGN_EPI) { if (wr == 0) PG8_BAR; }
    PG8_BAR;
    if constexpr (Epi::AFTER_DRAIN) { E.fused(acc, cur, wr, wc, fr, fq, lds, wid, lane); }
#undef PG8_SA
#undef PG8_SB
#undef PG8_STAGE
#undef PG8_LDA
#undef PG8_LDB
#undef PG8_MMA
#undef PG8_WAIT_V
#undef PG8_WAIT_L
#undef PG8_BAR
#undef PG8_SCHED
}

typedef f32x4 Acc[2][2][4][2];

struct EpiBf16 {
    static constexpr bool PERM = true, AFTER_DRAIN = false;
    bf16_t* O; int ldc; const float* ssq; float mul;
    __device__ __forceinline__ void operator()(const Acc& acc, const Unit& u, int wr, int wc, int fr, int fq) const {
        const int row0 = u.pm * BM + wr * 64 + fr, col0 = u.pn * BM + wc * 32 + 8 * fq;
#pragma unroll
        for (int ai = 0; ai < 2; ++ai)
#pragma unroll
            for (int m = 0; m < 4; ++m) { const int row = row0 + ai * HALF + m * 16; bf16_t* rowp = O + (size_t)row * ldc + col0;
                float sc = mul; if (ssq) sc *= rsqrtf(ssq[row] * (1.0f / DM) + RMS_EPS);
#pragma unroll
                for (int bj = 0; bj < 2; ++bj) { const f32x4 v0 = acc[ai][bj][m][0] * sc, v1 = acc[ai][bj][m][1] * sc;
                    u32x4 w; w.x = pk2(v0[0], v0[1]); w.y = pk2(v0[2], v0[3]); w.z = pk2(v1[0], v1[1]); w.w = pk2(v1[2], v1[3]);
                    *(u32x4*)(rowp + bj * HALF) = w; } }
    }
};
struct EpiSwiglu {
    static constexpr bool PERM = true, AFTER_DRAIN = false;
    bf16_t* O; const float* ssq;
    __device__ __forceinline__ void operator()(const Acc& acc, const Unit& u, int wr, int wc, int fr, int fq) const {
        const int row0 = u.pm * BM + wr * 64 + fr, col0 = u.pn * HALF + wc * 32 + 8 * fq;
#pragma unroll
        for (int ai = 0; ai < 2; ++ai)
#pragma unroll
            for (int m = 0; m < 4; ++m) { const int row = row0 + ai * HALF + m * 16;
                const float rs = rsqrtf(ssq[row] * (1.0f / DM) + RMS_EPS);
                float h[8];
#pragma unroll
                for (int n = 0; n < 2; ++n)
#pragma unroll
                    for (int e = 0; e < 4; ++e) { const float gg = acc[ai][0][m][n][e] * rs, uu = acc[ai][1][m][n][e] * rs; h[n * 4 + e] = silu_f(gg) * uu; }
                u32x4 w; w.x = pk2(h[0], h[1]); w.y = pk2(h[2], h[3]); w.z = pk2(h[4], h[5]); w.w = pk2(h[6], h[7]);
                *(u32x4*)(O + (size_t)row * DFF + col0) = w; }
    }
};
struct EpiRes {
    static constexpr bool PERM = false, AFTER_DRAIN = false;
    const float* res_p; const float* res_s;
    float* out; bf16_t* xb; float* ssq;
    __device__ __forceinline__ void operator()(const Acc& acc, const Unit& u, int wr, int wc, int fr, int fq) const {
        const int col0 = u.pn * BM + wc * 32 + 4 * fq;
        const float* rbase = (u.pm * BM < MP) ? res_p : (res_s - (size_t)MP * DM);
#pragma unroll
        for (int ai = 0; ai < 2; ++ai)
#pragma unroll
            for (int m = 0; m < 4; ++m) { const int row = u.pm * BM + ai * HALF + wr * 64 + m * 16 + fr; const size_t off = (size_t)row * DM + col0; float ss = 0.f;
#pragma unroll
                for (int bj = 0; bj < 2; ++bj)
#pragma unroll
                    for (int n = 0; n < 2; ++n) { const size_t o2 = off + bj * HALF + n * 16; const f32x4 bs = *(const f32x4*)(rbase + o2); const f32x4 o = bs + acc[ai][bj][m][n];
                        ss += (o[0] * o[0] + o[1] * o[1]) + (o[2] * o[2] + o[3] * o[3]);
                        *(f32x4*)(out + o2) = o;
                        if (xb) { u32x2 w; w.x = pk2(o[0], o[1]); w.y = pk2(o[2], o[3]); *(u32x2*)(xb + o2) = w; } }
                ss += __shfl_xor(ss, 16); ss += __shfl_xor(ss, 32);
                if (fq == 0) unsafeAtomicAdd(ssq + row, ss);
                asm volatile("" ::: "memory"); }
    }
};
struct EpiMemKV {
    static constexpr bool PERM = false, AFTER_DRAIN = false;
    float* outk; float* outv; bf16_t* mkb; bf16_t* vt;
    __device__ __forceinline__ void operator()(const Acc& acc, const Unit& u, int wr, int wc, int fr, int fq) const {
        const int col0 = u.pn * BM + wc * 32 + 4 * fq; const bool isv = col0 >= DM;
#pragma unroll
        for (int ai = 0; ai < 2; ++ai)
#pragma unroll
            for (int m = 0; m < 4; ++m) { const int row = u.pm * BM + ai * HALF + wr * 64 + m * 16 + fr;
#pragma unroll
                for (int bj = 0; bj < 2; ++bj)
#pragma unroll
                    for (int n = 0; n < 2; ++n) { const int c = col0 + bj * HALF + n * 16; const f32x4 o = acc[ai][bj][m][n];
                        if (!isv) { *(f32x4*)(outk + (size_t)row * DM + c) = o; u32x2 w; w.x = pk2(o[0], o[1]); w.y = pk2(o[2], o[3]); *(u32x2*)(mkb + (size_t)row * DM + c) = w; }
                        else { const int cv = c - DM; *(f32x4*)(outv + (size_t)row * DM + cv) = o; const int b = row >> 8, key = row & 255, h = cv >> 9, d = cv & 511;
                            bf16_t* p = vt + ((size_t)((b * XH + h) * XD + d)) * NMEM + key;
                            p[0] = (bf16_t)f2bf(o[0]); p[NMEM] = (bf16_t)f2bf(o[1]); p[2 * NMEM] = (bf16_t)f2bf(o[2]); p[3 * NMEM] = (bf16_t)f2bf(o[3]); } } }
    }
};
struct EpiSoftmax {
    static constexpr bool PERM = true, AFTER_DRAIN = true;
    bf16_t* P; int h;
    __device__ __forceinline__ void fused(Acc& acc, const Unit& u, int wr, int wc, int fr, int fq, LAS unsigned char* lds, int wid, int lane) const {
        LAS float* red = (LAS float*)lds; LAS float* red2 = red + 1024;
#pragma unroll
        for (int ai = 0; ai < 2; ++ai)
#pragma unroll
            for (int m = 0; m < 4; ++m) { float v = -3.0e38f;
#pragma unroll
                for (int bj = 0; bj < 2; ++bj)
#pragma unroll
                    for (int n = 0; n < 2; ++n) { const f32x4 x = acc[ai][bj][m][n]; v = fmaxf(v, fmaxf(fmaxf(x[0], x[1]), fmaxf(x[2], x[3]))); }
                v = fmaxf(v, __shfl_xor(v, 16)); v = fmaxf(v, __shfl_xor(v, 32));
                if (fq == 0) red[(ai * HALF + wr * 64 + m * 16 + fr) * 4 + wc] = v; }
        LDS_WAIT(); __builtin_amdgcn_s_barrier(); asm volatile("" ::: "memory");
#pragma unroll
        for (int ai = 0; ai < 2; ++ai)
#pragma unroll
            for (int m = 0; m < 4; ++m) { const int r = ai * HALF + wr * 64 + m * 16 + fr; const f32x4 t = *(const LAS f32x4*)(red + r * 4);
                const float mx = fmaxf(fmaxf(t[0], t[1]), fmaxf(t[2], t[3])); float s = 0.f;
#pragma unroll
                for (int bj = 0; bj < 2; ++bj)
#pragma unroll
                    for (int n = 0; n < 2; ++n) { f32x4 x = acc[ai][bj][m][n];
#pragma unroll
                        for (int e = 0; e < 4; ++e) { x[e] = __builtin_amdgcn_exp2f(x[e] - mx); s += x[e]; }
                        acc[ai][bj][m][n] = x; }
                s += __shfl_xor(s, 16); s += __shfl_xor(s, 32);
                if (fq == 0) red2[r * 4 + wc] = s; }
        LDS_WAIT(); __builtin_amdgcn_s_barrier(); asm volatile("" ::: "memory");
        const int b = u.pm >> 3, rb = u.pm & 7;
#pragma unroll
        for (int ai = 0; ai < 2; ++ai)
#pragma unroll
            for (int m = 0; m < 4; ++m) { const int r = ai * HALF + wr * 64 + m * 16 + fr; const f32x4 t = *(const LAS f32x4*)(red2 + r * 4);
                const float inv = 1.0f / ((t[0] + t[1]) + (t[2] + t[3]));
                bf16_t* rowp = P + ((size_t)((b * XH + h) * TP + rb * BM + r)) * NMEM + wc * 32 + 8 * fq;
#pragma unroll
                for (int bj = 0; bj < 2; ++bj) { const f32x4 v0 = acc[ai][bj][m][0] * inv, v1 = acc[ai][bj][m][1] * inv;
                    u32x4 w; w.x = pk2(v0[0], v0[1]); w.y = pk2(v0[2], v0[3]); w.z = pk2(v1[0], v1[1]); w.w = pk2(v1[2], v1[3]);
                    *(u32x4*)(rowp + bj * HALF) = w; } }
        LDS_WAIT(); __builtin_amdgcn_s_barrier(); asm volatile("" ::: "memory");
    }
};
struct EpiPV {
    static constexpr bool PERM = true, AFTER_DRAIN = false;
    bf16_t* AO;
    __device__ __forceinline__ void operator()(const Acc& acc, const Unit& u, int wr, int wc, int fr, int fq) const {
        const int bh = u.pm >> 3, rb = u.pm & 7, b = bh >> 2, h = bh & 3, ct = u.pn & 1;
        const int row0 = b * TP + rb * BM + wr * 64 + fr, col0 = h * XD + ct * BM + wc * 32 + 8 * fq;
#pragma unroll
        for (int ai = 0; ai < 2; ++ai)
#pragma unroll
            for (int m = 0; m < 4; ++m) { bf16_t* rowp = AO + (size_t)(row0 + ai * HALF + m * 16) * DM + col0;
#pragma unroll
                for (int bj = 0; bj < 2; ++bj) { const f32x4 v0 = acc[ai][bj][m][0], v1 = acc[ai][bj][m][1];
                    u32x4 w; w.x = pk2(v0[0], v0[1]); w.y = pk2(v0[2], v0[3]); w.z = pk2(v1[0], v1[1]); w.w = pk2(v1[2], v1[3]);
                    *(u32x4*)(rowp + bj * HALF) = w; } }
    }
};
}

struct Args { const float* in[23]; float* out; unsigned char* ws; int lo, hi, coop, pad; };

__device__ __forceinline__ void transpose_item(const float* W, int K, int N, bf16_t* WT, int drow, const float* gain, int k0, int n0, int lane) {
    const float* src = W + (size_t)k0 * N + n0 + lane;
    float v[64];
#pragma unroll
    for (int i = 0; i < 64; ++i) v[i] = src[(size_t)i * N];
    if (gain) {
#pragma unroll
        for (int i = 0; i < 64; ++i) v[i] *= gain[k0 + i];
    }
    bf16_t* dst = WT + (size_t)drow * K + k0;
#pragma unroll
    for (int c = 0; c < 8; ++c) { u32x4 o; o.x = pk2(v[8 * c], v[8 * c + 1]); o.y = pk2(v[8 * c + 2], v[8 * c + 3]); o.z = pk2(v[8 * c + 4], v[8 * c + 5]); o.w = pk2(v[8 * c + 6], v[8 * c + 7]);
        *(u32x4*)(dst + 8 * c) = o; }
}
__device__ __forceinline__ void rms_row_bf16(const float* x, const float* g, bf16_t* o, int lane) {
    const f32x4* xr = (const f32x4*)x + lane; f32x4 v[8]; float s = 0.f;
#pragma unroll
    for (int j = 0; j < 8; ++j) { v[j] = xr[64 * j]; s += (v[j][0] * v[j][0] + v[j][1] * v[j][1]) + (v[j][2] * v[j][2] + v[j][3] * v[j][3]); }
    const float rstd = rsqrtf(wave_sum(s) * (1.0f / DM) + RMS_EPS);
    const f32x4* gr = (const f32x4*)g + lane; u32x2* o8 = (u32x2*)o + lane;
#pragma unroll
    for (int j = 0; j < 8; ++j) { const f32x4 gg = gr[64 * j]; u32x2 w; w.x = pk2(v[j][0] * rstd * gg[0], v[j][1] * rstd * gg[1]); w.y = pk2(v[j][2] * rstd * gg[2], v[j][3] * rstd * gg[3]); o8[64 * j] = w; }
}
__device__ __forceinline__ void p0_prologue(const Args& a, LAS unsigned char* lds) {
    const int tid = threadIdx.x, lane = tid & 63, wave = tid >> 6, G = gridDim.x;
    unsigned char* ws = a.ws;
    { unsigned* ctl = (unsigned*)(ws + WS_CTL); for (int i = blockIdx.x * NTHR + tid; i < CW_N; i += G * NTHR) ctl[i] = 0u; }
    { float* rc = (float*)(ws + WS_ROPE); float* rs = rc + 2056 * 64;
      for (int i = blockIdx.x * NTHR + tid; i < 2056 * 64; i += G * NTHR) { const int idx = i >> 6, f = i & 63; const int pos = idx < 2048 ? idx : PAST + idx - 2048;
          const float inv = exp2f(-(float)f * (13.287712379549449f / 64.0f)); const float ang = (float)pos * inv;
          const double ad = (double)ang; const double k = __builtin_rint(ad * 0.15915494309189535); const float r = (float)(ad - k * 6.283185307179586);
          rc[i] = cosf(r); rs[i] = sinf(r); } }
    const int gw = blockIdx.x * 8 + wave, NGW = G * 8;
    constexpr int I_IN = 32 * 112, I_SQ = 32 * 32, I_FF = 32 * 88, I_DN = 88 * 32;
    constexpr int NITEMS = I_IN + 5 * I_SQ + 2 * I_FF + I_DN;
    for (int it = gw; it < NITEMS; it += NGW) {
        int r = it;
        if (r < I_IN) { const int kb = r / 112, nb = r % 112; transpose_item(a.in[8], DM, INC, (bf16_t*)(ws + WS_WIN), nb * 64 + lane, nullptr, kb * 64, nb * 64, lane); continue; } r -= I_IN;
        if (r < 5 * I_SQ) { const int w = r / I_SQ, q = r % I_SQ, kb = q / 32, nb = q % 32;
            const float* src; bf16_t* dst; const float* gain = nullptr; int roff = 0;
            if (w == 0) { src = a.in[11]; dst = (bf16_t*)(ws + WS_WMO); }
            else if (w == 1) { src = a.in[14]; dst = (bf16_t*)(ws + WS_WXQ); gain = a.in[13]; }
            else if (w == 2) { src = a.in[15]; dst = (bf16_t*)(ws + WS_WMKV); }
            else if (w == 3) { src = a.in[16]; dst = (bf16_t*)(ws + WS_WMKV); roff = DM; }
            else { src = a.in[17]; dst = (bf16_t*)(ws + WS_WXO); }
            transpose_item(src, DM, DM, dst, roff + nb * 64 + lane, gain, kb * 64, nb * 64, lane); continue; } r -= 5 * I_SQ;
        if (r < 2 * I_FF) { const int w = r / I_FF, q = r % I_FF, kb = q / 88, nb = q % 88, n = nb * 64 + lane;
            transpose_item(w == 0 ? a.in[19] : a.in[20], DM, DFF, (bf16_t*)(ws + WS_WGU), (n >> 7) * 256 + w * 128 + (n & 127), a.in[18], kb * 64, nb * 64, lane); continue; } r -= 2 * I_FF;
        { const int kb = r / 32, nb = r % 32; transpose_item(a.in[21], DFF, DM, (bf16_t*)(ws + WS_WD), nb * 64 + lane, nullptr, kb * 64, nb * 64, lane); }
    }
    for (int m = gw; m < MT + BP * NMEM; m += NGW) {
        if (m < MP) rms_row_bf16(a.in[0] + (size_t)m * DM, a.in[7], (bf16_t*)(ws + WS_H1) + (size_t)m * DM, lane);
        else if (m < MT) rms_row_bf16(a.in[1] + (size_t)(m - MP) * DM, a.in[7], (bf16_t*)(ws + WS_H1) + (size_t)m * DM, lane);
        else rms_row_bf16(a.in[2] + (size_t)(m - MT) * DM, a.in[12], (bf16_t*)(ws + WS_HM) + (size_t)(m - MT) * DM, lane);
    }
}

constexpr int RP = 136;
constexpr int RTILE = 128 * RP * 2;
__device__ __forceinline__ bf16x8 rfrag(const LAS unsigned char* tile, int row, int ks, int fq) { return *(const LAS bf16x8*)(tile + (row * RP + 32 * ks + 8 * fq) * 2); }
__device__ __forceinline__ float ret_lg2(int h) { return log2f(1.0f - exp2f(-5.0f - (float)h)); }

template <bool TRANSPOSE> __device__ __forceinline__ void stage_rot(const bf16_t* Z, int r0, int coff, int posidx0, const float* ropeC, const float* ropeS, LAS unsigned char* dst, float scale, float lg2, bool decay) {
    const int tid = threadIdx.x, j = tid >> 2, dq = tid & 3;
    const bf16_t* src = Z + (size_t)(r0 + j) * INC + coff + 16 * dq;
    const u32x4 a0 = *(const u32x4*)(src), a1 = *(const u32x4*)(src + 8), b0 = *(const u32x4*)(src + 64), b1 = *(const u32x4*)(src + 72);
    const float* cs = ropeC + (size_t)(posidx0 + j) * 64 + 16 * dq; const float* sn = ropeS + (size_t)(posidx0 + j) * 64 + 16 * dq;
    float sc = scale; if (decay) sc *= exp2f((float)(127 - j) * lg2);
    float y1[16], y2[16];
#pragma unroll
    for (int e = 0; e < 16; ++e) { const unsigned wa = (e < 8) ? a0[(e & 7) >> 1] : a1[(e & 7) >> 1]; const unsigned wb = (e < 8) ? b0[(e & 7) >> 1] : b1[(e & 7) >> 1];
        const float x1 = (e & 1) ? bfhi(wa) : bflo(wa), x2 = (e & 1) ? bfhi(wb) : bflo(wb); const float c = cs[e], s = sn[e];
        y1[e] = (x1 * c - x2 * s) * sc; y2[e] = (x1 * s + x2 * c) * sc; }
    if (TRANSPOSE) {
        LAS bf16_t* d = (LAS bf16_t*)dst;
#pragma unroll
        for (int e = 0; e < 16; ++e) { d[(16 * dq + e) * RP + j] = (bf16_t)f2bf(y1[e]); d[(64 + 16 * dq + e) * RP + j] = (bf16_t)f2bf(y2[e]); }
    } else {
        LAS unsigned char* p = dst + (j * RP + 16 * dq) * 2;
        u32x4 w;
        w.x = pk2(y1[0], y1[1]); w.y = pk2(y1[2], y1[3]); w.z = pk2(y1[4], y1[5]); w.w = pk2(y1[6], y1[7]); *(LAS u32x4*)(p) = w;
        w.x = pk2(y1[8], y1[9]); w.y = pk2(y1[10], y1[11]); w.z = pk2(y1[12], y1[13]); w.w = pk2(y1[14], y1[15]); *(LAS u32x4*)(p + 16) = w;
        w.x = pk2(y2[0], y2[1]); w.y = pk2(y2[2], y2[3]); w.z = pk2(y2[4], y2[5]); w.w = pk2(y2[6], y2[7]); *(LAS u32x4*)(p + 128) = w;
        w.x = pk2(y2[8], y2[9]); w.y = pk2(y2[10], y2[11]); w.z = pk2(y2[12], y2[13]); w.w = pk2(y2[14], y2[15]); *(LAS u32x4*)(p + 144) = w;
    }
}
__device__ __forceinline__ void stage_vt(const bf16_t* Z, int r0, int coff, LAS unsigned char* dst) {
    const int tid = threadIdx.x, j = tid >> 2, eq = tid & 3;
    const bf16_t* src = Z + (size_t)(r0 + j) * INC + coff + 32 * eq;
    LAS bf16_t* d = (LAS bf16_t*)dst;
#pragma unroll
    for (int q = 0; q < 4; ++q) { const u32x4 v = *(const u32x4*)(src + 8 * q);
#pragma unroll
        for (int e = 0; e < 8; ++e) { const unsigned w = v[e >> 1]; d[(32 * eq + 8 * q + e) * RP + j] = (bf16_t)((e & 1) ? (w >> 16) : (w & 0xffffu)); } }
}

__device__ __forceinline__ void r1_unit(const Args& a, LAS unsigned char* lds, int unit) {
    const int tid = threadIdx.x, lane = tid & 63, w = tid >> 6, fr = lane & 15, fq = lane >> 4;
    const int bh = unit >> 4, c = unit & 15, b = bh >> 3, h = bh & 7;
    const bf16_t* Z = (const bf16_t*)(a.ws + WS_Z); const float* ropeC = (const float*)(a.ws + WS_ROPE); const float* ropeS = ropeC + 2056 * 64;
    const int r0 = b * TP + c * 128; const float lg2 = ret_lg2(h);
    LAS unsigned char* KT = lds + RTILE; LAS unsigned char* VT = lds + 2 * RTILE;
    stage_rot<true>(Z, r0, ZK + h * RD, c * 128, ropeC, ropeS, KT, KSCALE, lg2, true);
    stage_vt(Z, r0, ZV + h * RD, VT);
    __syncthreads();
    f32x4 acc[8];
#pragma unroll
    for (int t = 0; t < 8; ++t) acc[t] = (f32x4){0.f, 0.f, 0.f, 0.f};
#pragma unroll
    for (int ks = 0; ks < 4; ++ks) { const bf16x8 y = rfrag(VT, 16 * w + fr, ks, fq);
#pragma unroll
        for (int t = 0; t < 8; ++t) { const bf16x8 x = rfrag(KT, 16 * t + fr, ks, fq); acc[t] = __builtin_amdgcn_mfma_f32_16x16x32_bf16(x, y, acc[t], 0, 0, 0); } }
    float* kv = (float*)(a.ws + WS_KV) + ((size_t)unit * 128 + 16 * w + fr) * 128 + 4 * fq;
#pragma unroll
    for (int t = 0; t < 8; ++t) *(f32x4*)(kv + 16 * t) = acc[t];
    __syncthreads();
}

__device__ __forceinline__ void r2_unit(const Args& a, LAS unsigned char* lds, int bh, int c) {
    const int tid = threadIdx.x, lane = tid & 63, w = tid >> 6, fr = lane & 15, fq = lane >> 4;
    const int b = bh >> 3, h = bh & 7;
    const bf16_t* Z = (const bf16_t*)(a.ws + WS_Z); const float* ropeC = (const float*)(a.ws + WS_ROPE); const float* ropeS = ropeC + 2056 * 64;
    const int r0 = b * TP + c * 128; const float lg2 = ret_lg2(h);
    LAS unsigned char* QL = lds; LAS unsigned char* KL = lds + RTILE; LAS unsigned char* VT = lds + 2 * RTILE; LAS unsigned char* ST = lds + 3 * RTILE;
    stage_rot<false>(Z, r0, ZQ + h * RD, c * 128, ropeC, ropeS, QL, 1.0f, lg2, false);
    stage_rot<false>(Z, r0, ZK + h * RD, c * 128, ropeC, ropeS, KL, KSCALE, lg2, false);
    stage_vt(Z, r0, ZV + h * RD, VT);
    {
        const float cd = exp2f(128.0f * lg2);
        f32x4 s[8];
#pragma unroll
        for (int k = 0; k < 8; ++k) s[k] = (f32x4){0.f, 0.f, 0.f, 0.f};
        const float* kv = (const float*)(a.ws + WS_KV) + (size_t)(bh * 16) * 16384 + tid * 4;
        const float cd2 = cd * cd;
        int j = 0;
        for (; j + 2 <= c; j += 2) { f32x4 v0[8], v1[8];
#pragma unroll
            for (int k = 0; k < 8; ++k) { const float* p = kv + (size_t)j * 16384 + k * 2048; v0[k] = *(const f32x4*)(p); v1[k] = *(const f32x4*)(p + 16384); }
#pragma unroll
            for (int k = 0; k < 8; ++k) s[k] = s[k] * cd2 + (v0[k] * cd + v1[k]); }
        for (; j < c; ++j) {
#pragma unroll
            for (int k = 0; k < 8; ++k) { const f32x4 v = *(const f32x4*)(kv + (size_t)j * 16384 + k * 2048); s[k] = s[k] * cd + v; } }
#pragma unroll
        for (int k = 0; k < 8; ++k) { const int idx = tid + 512 * k, e = idx >> 5, d4 = (idx & 31) * 4; u32x2 wv; wv.x = pk2(s[k][0], s[k][1]); wv.y = pk2(s[k][2], s[k][3]);
            *(LAS u32x2*)(ST + (e * RP + d4) * 2) = wv; }
        if (c == 15) {
            float* so = a.out + O_SRP + (size_t)bh * 16384;
#pragma unroll
            for (int k = 0; k < 8; ++k) { const f32x4 v = *(const f32x4*)(kv + (size_t)15 * 16384 + k * 2048); const f32x4 f = s[k] * cd + v;
                const int idx = tid + 512 * k, e = idx >> 5, d4 = (idx & 31) * 4;
                so[(d4 + 0) * 128 + e] = f[0]; so[(d4 + 1) * 128 + e] = f[1]; so[(d4 + 2) * 128 + e] = f[2]; so[(d4 + 3) * 128 + e] = f[3]; }
        }
    }
    __syncthreads();
    const int il = 16 * w + fr;
    bf16x8 yq[4];
#pragma unroll
    for (int ks = 0; ks < 4; ++ks) yq[ks] = rfrag(QL, il, ks, fq);
    f32x4 o[8], sc[8];
#pragma unroll
    for (int t = 0; t < 8; ++t) { o[t] = (f32x4){0.f, 0.f, 0.f, 0.f}; sc[t] = (f32x4){0.f, 0.f, 0.f, 0.f}; }
#pragma unroll
    for (int ks = 0; ks < 4; ++ks)
#pragma unroll
        for (int t = 0; t < 8; ++t) { const bf16x8 x = rfrag(ST, 16 * t + fr, ks, fq); o[t] = __builtin_amdgcn_mfma_f32_16x16x32_bf16(x, yq[ks], o[t], 0, 0, 0); }
    const float qd = exp2f((float)(il + 1) * lg2);
#pragma unroll
    for (int t = 0; t < 8; ++t) o[t] = o[t] * qd;
#pragma unroll
    for (int ks = 0; ks < 4; ++ks)
#pragma unroll
        for (int t = 0; t < 8; ++t) { const bf16x8 x = rfrag(KL, 16 * t + fr, ks, fq); sc[t] = __builtin_amdgcn_mfma_f32_16x16x32_bf16(x, yq[ks], sc[t], 0, 0, 0); }
    __syncthreads();
#pragma unroll
    for (int t = 0; t < 8; ++t) { float p[4];
#pragma unroll
        for (int r = 0; r < 4; ++r) { const int j = 16 * t + 4 * fq + r; p[r] = (j <= il) ? sc[t][r] * exp2f((float)(il - j) * lg2) : 0.f; }
        u32x2 wv; wv.x = pk2(p[0], p[1]); wv.y = pk2(p[2], p[3]); *(LAS u32x2*)(ST + (il * RP + 16 * t + 4 * fq) * 2) = wv; }
    LDS_WAIT();
#pragma unroll
    for (int ks = 0; ks < 4; ++ks) { const bf16x8 y = rfrag(ST, il, ks, fq);
#pragma unroll
        for (int t = 0; t < 8; ++t) { const bf16x8 x = rfrag(VT, 16 * t + fr, ks, fq); o[t] = __builtin_amdgcn_mfma_f32_16x16x32_bf16(x, y, o[t], 0, 0, 0); } }
    float s1 = 0.f;
#pragma unroll
    for (int t = 0; t < 8; ++t) s1 += (o[t][0] + o[t][1]) + (o[t][2] + o[t][3]);
    s1 += __shfl_xor(s1, 16); s1 += __shfl_xor(s1, 32);
    const float mu = s1 * (1.0f / 128.0f); float s2 = 0.f;
#pragma unroll
    for (int t = 0; t < 8; ++t) { o[t] = o[t] - mu; s2 += (o[t][0] * o[t][0] + o[t][1] * o[t][1]) + (o[t][2] * o[t][2] + o[t][3] * o[t][3]); }
    s2 += __shfl_xor(s2, 16); s2 += __shfl_xor(s2, 32);
    const float rstd = rsqrtf(s2 * (1.0f / 128.0f) + GN_EPS);
    const int row = r0 + il; const float* gn = a.in[10] + h * RD; const bf16_t* gz = Z + (size_t)row * INC + ZG + h * RD; bf16_t* mix = (bf16_t*)(a.ws + WS_MIX) + (size_t)row * DM + h * RD;
#pragma unroll
    for (int t = 0; t < 8; ++t) { const int e0 = 16 * t + 4 * fq; const f32x4 gg = *(const f32x4*)(gn + e0); const u32x2 gw = *(const u32x2*)(gz + e0);
        const float g0 = bflo(gw.x), g1 = bfhi(gw.x), g2 = bflo(gw.y), g3 = bfhi(gw.y);
        u32x2 wv; wv.x = pk2(silu_f(g0) * o[t][0] * rstd * gg[0], silu_f(g1) * o[t][1] * rstd * gg[1]); wv.y = pk2(silu_f(g2) * o[t][2] * rstd * gg[2], silu_f(g3) * o[t][3] * rstd * gg[3]);
        *(u32x2*)(mix + e0) = wv; }
    __syncthreads();
}

__device__ __forceinline__ void rs_unit(const Args& a, LAS unsigned char* lds, int unit) {
    const int tid = threadIdx.x, lane = tid & 63, w = tid >> 6;
    const int bs = unit >> 3, h = unit & 7; const float lg2 = ret_lg2(h);
    const bf16_t* Z = (const bf16_t*)(a.ws + WS_Z); const float* ropeC = (const float*)(a.ws + WS_ROPE); const float* ropeS = ropeC + 2056 * 64;
    const int r0 = MP + bs * TS;
    LAS float* qT = (LAS float*)lds;
    LAS float* kT = qT + 1024;
    LAS float* vL = kT + 1024;
    LAS float* scL = vL + 1024;
    LAS float* red = scL + 64;
    {
        const int which = tid >> 8, i = (tid >> 5) & 7, d = 2 * (tid & 31);
        const bf16_t* src = Z + (size_t)(r0 + i) * INC + (which ? ZK : ZQ) + h * RD + d;
        const unsigned wa = *(const unsigned*)src, wb = *(const unsigned*)(src + 64);
        const float* cs = ropeC + (size_t)(2048 + i) * 64 + d; const float* sn = ropeS + (size_t)(2048 + i) * 64 + d;
        const float sc = which ? KSCALE * exp2f((float)(7 - i) * lg2) : 1.0f;
        LAS float* dst = which ? kT : qT;
        { const float x1 = bflo(wa), x2 = bflo(wb), c = cs[0], s = sn[0]; dst[d * 8 + i] = (x1 * c - x2 * s) * sc; dst[(d + 64) * 8 + i] = (x1 * s + x2 * c) * sc; }
        { const float x1 = bfhi(wa), x2 = bfhi(wb), c = cs[1], s = sn[1]; dst[(d + 1) * 8 + i] = (x1 * c - x2 * s) * sc; dst[(d + 65) * 8 + i] = (x1 * s + x2 * c) * sc; }
        const int j = tid >> 6, e = 2 * (tid & 63); const unsigned wv = *(const unsigned*)(Z + (size_t)(r0 + j) * INC + ZV + h * RD + e);
        vL[j * 128 + e] = bflo(wv); vL[j * 128 + e + 1] = bfhi(wv);
    }
    __syncthreads();
    {
        const int pr = tid >> 3, i = pr >> 3, j = pr & 7, part = tid & 7; float s = 0.f;
#pragma unroll
        for (int d = 0; d < 16; ++d) s += qT[(part * 16 + d) * 8 + i] * kT[(part * 16 + d) * 8 + j];
        s += __shfl_xor(s, 1); s += __shfl_xor(s, 2); s += __shfl_xor(s, 4);
        if (part == 0) scL[i * 8 + j] = (j <= i) ? s * exp2f((float)(i - 7) * lg2) : 0.f;
    }
    {
        const int e = tid & 127, dg = tid >> 7; const float cd = exp2f(8.0f * lg2);
        float vr[8], cr[8];
#pragma unroll
        for (int j = 0; j < 8; ++j) { vr[j] = vL[j * 128 + e]; cr[j] = 0.f; }
        const float* s0 = a.in[3] + ((size_t)unit * 128 + dg * 32) * 128 + e; float* so = a.out + O_SRS + ((size_t)unit * 128 + dg * 32) * 128 + e;
        float sv[32];
#pragma unroll
        for (int d = 0; d < 32; ++d) sv[d] = s0[d * 128];
#pragma unroll
        for (int d = 0; d < 32; ++d) { const float s = sv[d]; const int dd = dg * 32 + d;
            const f32x4 q0 = *(const LAS f32x4*)(qT + dd * 8), q1 = *(const LAS f32x4*)(qT + dd * 8 + 4), k0 = *(const LAS f32x4*)(kT + dd * 8), k1 = *(const LAS f32x4*)(kT + dd * 8 + 4);
            float sn = s * cd;
#pragma unroll
            for (int i = 0; i < 4; ++i) { cr[i] += q0[i] * s; cr[i + 4] += q1[i] * s; sn += k0[i] * vr[i]; sn += k1[i] * vr[i + 4]; }
            so[d * 128] = sn; }
#pragma unroll
        for (int i = 0; i < 8; ++i) red[(dg * 8 + i) * 128 + e] = cr[i];
    }
    __syncthreads();
    {
        const int i = w; const float qd = exp2f((float)(i + 1) * lg2); float o[2];
#pragma unroll
        for (int q = 0; q < 2; ++q) { const int e = lane + 64 * q; float v = (red[(0 * 8 + i) * 128 + e] + red[(1 * 8 + i) * 128 + e]) + (red[(2 * 8 + i) * 128 + e] + red[(3 * 8 + i) * 128 + e]); v *= qd;
#pragma unroll
            for (int j = 0; j < 8; ++j) v += scL[i * 8 + j] * vL[j * 128 + e];
            o[q] = v; }
        const float mu = wave_sum(o[0] + o[1]) * (1.0f / 128.0f); o[0] -= mu; o[1] -= mu;
        const float rstd = rsqrtf(wave_sum(o[0] * o[0] + o[1] * o[1]) * (1.0f / 128.0f) + GN_EPS);
        const int row = r0 + i;
#pragma unroll
        for (int q = 0; q < 2; ++q) { const int e = lane + 64 * q; const float g = bf2f(Z[(size_t)row * INC + ZG + h * RD + e]);
            ((bf16_t*)(a.ws + WS_MIX))[(size_t)row * DM + h * RD + e] = (bf16_t)f2bf(silu_f(g) * o[q] * rstd * a.in[10][h * RD + e]); }
    }
    __syncthreads();
}

__device__ __forceinline__ void conv_block(const Args& a, int blk) {
    const int tid = threadIdx.x, grp = tid >> 7, c = (tid & 127) * 8;
    const int r0 = blk * 36 + grp * 9;
    const bf16_t* Z = (const bf16_t*)(a.ws + WS_Z);
    u32x4 cgv[11], hnv[11], bgv[9];
#pragma unroll
    for (int i = 0; i < 11; ++i) { const int row = r0 - 2 + i;
        if (row >= 0) { const bf16_t* zr = Z + (size_t)row * INC; cgv[i] = *(const u32x4*)(zr + ZCG + c); hnv[i] = *(const u32x4*)(zr + ZHIN + c); }
        else { cgv[i] = (u32x4){0u, 0u, 0u, 0u}; hnv[i] = cgv[i]; } }
#pragma unroll
    for (int i = 0; i < 9; ++i) bgv[i] = *(const u32x4*)(Z + (size_t)(r0 + i) * INC + ZBG + c);
    const float* cw = a.in[9] + c;
    float w0[8], w1[8], w2[8];
    { const f32x4 x0 = *(const f32x4*)(cw), x1 = *(const f32x4*)(cw + 4), y0 = *(const f32x4*)(cw + 1024), y1 = *(const f32x4*)(cw + 1028), z0 = *(const f32x4*)(cw + 2048), z1 = *(const f32x4*)(cw + 2052);
#pragma unroll
      for (int e = 0; e < 4; ++e) { w0[e] = x0[e]; w0[e + 4] = x1[e]; w1[e] = y0[e]; w1[e + 4] = y1[e]; w2[e] = z0[e]; w2[e + 4] = z1[e]; } }
#pragma unroll
    for (int i = 0; i < 9; ++i) { const int row = r0 + i;
        int t, T; const float* cbuf = nullptr; float* sout;
        if (row < MP) { t = row & (TP - 1); T = TP; sout = a.out + O_SCP + (size_t)(row >> 11) * 2048; }
        else { const int r = row - MP; t = r & 7; T = TS; cbuf = a.in[4] + (size_t)(r >> 3) * 2048; sout = a.out + O_SCS + (size_t)(r >> 3) * 2048; }
        float u2[8], u1[8], u0[8];
#pragma unroll
        for (int e = 0; e < 8; ++e) { const unsigned wc2 = cgv[i + 2][e >> 1], wh2 = hnv[i + 2][e >> 1], wc1 = cgv[i + 1][e >> 1], wh1 = hnv[i + 1][e >> 1], wc0 = cgv[i][e >> 1], wh0 = hnv[i][e >> 1];
            u2[e] = (e & 1) ? bfhi(wc2) * bfhi(wh2) : bflo(wc2) * bflo(wh2);
            u1[e] = (e & 1) ? bfhi(wc1) * bfhi(wh1) : bflo(wc1) * bflo(wh1);
            u0[e] = (e & 1) ? bfhi(wc0) * bfhi(wh0) : bflo(wc0) * bflo(wh0); }
        if (t < 2) {
            if (cbuf) { const f32x4 p0 = *(const f32x4*)(cbuf + t * 1024 + c), p1 = *(const f32x4*)(cbuf + t * 1024 + c + 4);
#pragma unroll
                for (int e = 0; e < 4; ++e) { u0[e] = p0[e]; u0[e + 4] = p1[e]; }
                if (t == 0) { const f32x4 q0 = *(const f32x4*)(cbuf + 1024 + c), q1 = *(const f32x4*)(cbuf + 1024 + c + 4);
#pragma unroll
                    for (int e = 0; e < 4; ++e) { u1[e] = q0[e]; u1[e + 4] = q1[e]; } } }
            else {
#pragma unroll
                for (int e = 0; e < 8; ++e) { u0[e] = 0.f; if (t == 0) u1[e] = 0.f; } } }
        float o[8];
#pragma unroll
        for (int e = 0; e < 8; ++e) { const unsigned wb = bgv[i][e >> 1]; const float bg = (e & 1) ? bfhi(wb) : bflo(wb); o[e] = bg * (w0[e] * u0[e] + w1[e] * u1[e] + w2[e] * u2[e]); }
        u32x4 ow; ow.x = pk2(o[0], o[1]); ow.y = pk2(o[2], o[3]); ow.z = pk2(o[4], o[5]); ow.w = pk2(o[6], o[7]);
        *(u32x4*)((bf16_t*)(a.ws + WS_MIX) + (size_t)row * DM + 1024 + c) = ow;
        if (t >= T - 2) { float* sp = sout + (t - (T - 2)) * 1024 + c; *(f32x4*)(sp) = (f32x4){u2[0], u2[1], u2[2], u2[3]}; *(f32x4*)(sp + 4) = (f32x4){u2[4], u2[5], u2[6], u2[7]}; } }
}

__device__ __forceinline__ void sa_unit(const Args& a, LAS unsigned char* lds, int unit) {
    const int tid = threadIdx.x, lane = tid & 63, w = tid >> 6;
    const int bs = unit >> 2, h = unit & 3;
    LAS float* SL = (LAS float*)lds;
    LAS float* PT = SL + 2048;
    LAS float* OR = PT + 2048;
    const bf16_t* Qb = (const bf16_t*)(a.ws + WS_Q) + (size_t)(MP + bs * TS) * DM + h * XD;
    float q[8][8];
#pragma unroll
    for (int r = 0; r < 8; ++r) { const u32x2 w0 = *(const u32x2*)(Qb + (size_t)r * DM + 4 * lane), w1 = *(const u32x2*)(Qb + (size_t)r * DM + 256 + 4 * lane);
        q[r][0] = bflo(w0.x); q[r][1] = bfhi(w0.x); q[r][2] = bflo(w0.y); q[r][3] = bfhi(w0.y); q[r][4] = bflo(w1.x); q[r][5] = bfhi(w1.x); q[r][6] = bflo(w1.y); q[r][7] = bfhi(w1.y); }
    const float* Kb = a.in[5] + ((size_t)(bs * NMEM) * XH + h) * XD;
    const int rsel = 4 * (lane & 1) + 2 * ((lane >> 1) & 1) + ((lane >> 2) & 1);
    for (int kk = 0; kk < 32; kk += 4) {
        f32x4 k0[4], k1[4];
#pragma unroll
        for (int u = 0; u < 4; ++u) { const float* p = Kb + (size_t)(32 * w + kk + u) * (XH * XD); k0[u] = *(const f32x4*)(p + 4 * lane); k1[u] = *(const f32x4*)(p + 256 + 4 * lane); }
#pragma unroll
        for (int u = 0; u < 4; ++u) { float p8[8];
#pragma unroll
            for (int r = 0; r < 8; ++r) p8[r] = (q[r][0] * k0[u][0] + q[r][1] * k0[u][1]) + (q[r][2] * k0[u][2] + q[r][3] * k0[u][3]) + (q[r][4] * k1[u][0] + q[r][5] * k1[u][1]) + (q[r][6] * k1[u][2] + q[r][7] * k1[u][3]);
            float q4[4], q2[2], q1;
#pragma unroll
            for (int i = 0; i < 4; ++i) { const float send = (lane & 1) ? p8[i] : p8[i + 4], keep = (lane & 1) ? p8[i + 4] : p8[i]; q4[i] = keep + __shfl_xor(send, 1); }
#pragma unroll
            for (int i = 0; i < 2; ++i) { const float send = (lane & 2) ? q4[i] : q4[i + 2], keep = (lane & 2) ? q4[i + 2] : q4[i]; q2[i] = keep + __shfl_xor(send, 2); }
            { const float send = (lane & 4) ? q2[0] : q2[1], keep = (lane & 4) ? q2[1] : q2[0]; q1 = keep + __shfl_xor(send, 4); }
            q1 += __shfl_xor(q1, 8); q1 += __shfl_xor(q1, 16); q1 += __shfl_xor(q1, 32);
            if (lane < 8) SL[rsel * 256 + 32 * w + kk + u] = q1; }
    }
    __syncthreads();
    {
        float v[4]; float mx = -3.0e38f;
#pragma unroll
        for (int i = 0; i < 4; ++i) { v[i] = SL[w * 256 + lane + 64 * i]; mx = fmaxf(mx, v[i]); }
        mx = wave_max(mx); float s = 0.f;
#pragma unroll
        for (int i = 0; i < 4; ++i) { v[i] = __builtin_amdgcn_exp2f(v[i] - mx); s += v[i]; }
        const float inv = 1.0f / wave_sum(s);
#pragma unroll
        for (int i = 0; i < 4; ++i) PT[(lane + 64 * i) * 8 + w] = v[i] * inv;
    }
    __syncthreads();
    {
        const int g = tid >> 7, c = tid & 127;
        const float* Vb = a.in[6] + ((size_t)(bs * NMEM + g * 64) * XH + h) * XD + 4 * c;
        f32x4 acc[8];
#pragma unroll
        for (int r = 0; r < 8; ++r) acc[r] = (f32x4){0.f, 0.f, 0.f, 0.f};
        for (int k8 = 0; k8 < 64; k8 += 8) { f32x4 v[8];
#pragma unroll
            for (int u = 0; u < 8; ++u) v[u] = *(const f32x4*)(Vb + (size_t)(k8 + u) * (XH * XD));
#pragma unroll
            for (int u = 0; u < 8; ++u) { const int key = g * 64 + k8 + u; const f32x4 p0 = *(const LAS f32x4*)(PT + key * 8), p1 = *(const LAS f32x4*)(PT + key * 8 + 4);
#pragma unroll
                for (int r = 0; r < 4; ++r) { acc[r] = acc[r] + v[u] * p0[r]; acc[r + 4] = acc[r + 4] + v[u] * p1[r]; } } }
#pragma unroll
        for (int r = 0; r < 8; ++r) *(LAS f32x4*)(OR + (g * 8 + r) * 512 + 4 * c) = acc[r];
    }
    __syncthreads();
    {
        f32x4 s0 = (f32x4){0.f, 0.f, 0.f, 0.f}, s1 = s0;
#pragma unroll
        for (int g = 0; g < 4; ++g) { s0 = s0 + *(const LAS f32x4*)(OR + (g * 8 + w) * 512 + 8 * lane); s1 = s1 + *(const LAS f32x4*)(OR + (g * 8 + w) * 512 + 8 * lane + 4); }
        u32x4 o; o.x = pk2(s0[0], s0[1]); o.y = pk2(s0[2], s0[3]); o.z = pk2(s1[0], s1[1]); o.w = pk2(s1[2], s1[3]);
        *(u32x4*)((bf16_t*)(a.ws + WS_AO) + (size_t)(MP + bs * TS + w) * DM + h * XD + 8 * lane) = o;
    }
    __syncthreads();
}


#define XB_TMO      128
#define XB_XCNT(j)  (256  + 64 * (j))
#define XB_XSUB(j)  (1280 + 64 * (j))
#define XB_XGEN(j)  (2304 + 64 * (j))
#define XB_TOP      3328
#define XB_TOPGEN   3392
#define XCD_BAR_WORDS 3456
#define XB_SPIN_CAP (1u << 18)
__device__ __forceinline__ unsigned xb_ld(unsigned* p)              { return __hip_atomic_load(p, __ATOMIC_RELAXED, __HIP_MEMORY_SCOPE_AGENT); }
__device__ __forceinline__ unsigned xb_add(unsigned* p, unsigned v) { return __hip_atomic_fetch_add(p, v, __ATOMIC_RELAXED, __HIP_MEMORY_SCOPE_AGENT); }
__device__ __forceinline__ unsigned xb_xcc_id() { return (unsigned)__builtin_amdgcn_s_getreg((3 << 11) | 20) & 0xFu; }
#define XB_SPIN(cond, bar) do { unsigned _sp = 0; while (cond) { __builtin_amdgcn_s_sleep(1); \
    if ((++_sp & 255u) == 0u) { if (xb_ld(&(bar)[XB_TMO])) break; if (_sp > XB_SPIN_CAP) { atomicAdd(&(bar)[XB_TMO], 1u); break; } } } } while (0)
struct XcdBarrier { unsigned* bar; unsigned x; volatile LAS unsigned* st; };
__device__ __forceinline__ XcdBarrier xcd_barrier_post(unsigned* bar, volatile LAS unsigned* st) {
    XcdBarrier b; b.bar = bar; b.x = xb_xcc_id(); b.st = st;
    if (threadIdx.x == 0) (void)xb_add(&bar[XB_XCNT(b.x)], 1u);
    return b;
}
__device__ __forceinline__ void xcd_barrier_complete(unsigned* bar, unsigned x, unsigned& nloc, unsigned& nx) {
    const unsigned G = gridDim.x * gridDim.y * gridDim.z;
    unsigned sum, cnt, mine, sp = 0u;
    for (;;) {
        sum = 0u; cnt = 0u; mine = 0u;
#pragma unroll
        for (unsigned j = 0; j < 16; ++j) { const unsigned c = xb_ld(&bar[XB_XCNT(j)]); sum += c; cnt += (c > 0u) ? 1u : 0u; mine = (j == x) ? c : mine; }
        if (sum == G) break;
        __builtin_amdgcn_s_sleep(1);
        if ((++sp & 255u) == 0u) { if (xb_ld(&bar[XB_TMO])) break; if (sp > XB_SPIN_CAP) { atomicAdd(&bar[XB_TMO], 1u); break; } }
    }
    nloc = mine > 0u ? mine : 1u; nx = cnt > 0u ? cnt : 1u;
}
__device__ __forceinline__ void xcd_barrier(const XcdBarrier& b) {
    asm volatile("s_waitcnt vmcnt(0)" ::: "memory");
    __syncthreads();
    if (threadIdx.x == 0) {
        unsigned* bar = b.bar;
        __builtin_amdgcn_s_waitcnt(0);
        unsigned nloc = b.st[0], nx = b.st[1];
        if (nloc == 0u) { xcd_barrier_complete(bar, b.x, nloc, nx); b.st[0] = nloc; b.st[1] = nx; }
        const unsigned old = xb_add(&bar[XB_XSUB(b.x)], 1u);
        const unsigned gen = old / nloc;
        if (old + 1u == (gen + 1u) * nloc) {
            __builtin_amdgcn_fence(__ATOMIC_RELEASE, "agent");
            asm volatile("s_waitcnt vmcnt(0)" ::: "memory");
            const unsigned og = xb_add(&bar[XB_TOP], 1u);
            const unsigned tg = og / nx;
            if (og + 1u == (tg + 1u) * nx) xb_add(&bar[XB_TOPGEN], 1u);
            else XB_SPIN(xb_ld(&bar[XB_TOPGEN]) == tg, bar);
            __builtin_amdgcn_fence(__ATOMIC_ACQUIRE, "agent");
            xb_add(&bar[XB_XGEN(b.x)], 1u);
            asm volatile("s_waitcnt vmcnt(0)" ::: "memory");
        } else {
            XB_SPIN(xb_ld(&bar[XB_XGEN(b.x)]) == gen, bar);
            __builtin_amdgcn_fence(__ATOMIC_ACQUIRE, "agent");
            asm volatile("s_waitcnt vmcnt(0)" ::: "memory");
        }
    }
    __syncthreads();
}

__global__ void __launch_bounds__(NTHR, 2) fwd_kernel(Args a) {
    extern __shared__ __attribute__((aligned(16))) unsigned char lds_raw[];
    LAS unsigned char* lds = (LAS unsigned char*)lds_raw;
    cg::grid_group grid = cg::this_grid();
    const int tid = threadIdx.x, lane = tid & 63, wave = tid >> 6, G = gridDim.x, bid = blockIdx.x;
    unsigned char* ws = a.ws;
    float* ctlf = (float*)(ws + WS_CTL);
    const int lo = a.lo, hi = a.hi;
    volatile LAS unsigned* xst = (volatile LAS unsigned*)(lds + LDS_BYTES - 64);
    if (tid < 2) xst[tid] = 0u;
    __syncthreads();
    XcdBarrier xbar; xbar.bar = (unsigned*)(ws + WS_CTL) + CW_BAR; xbar.x = 0; xbar.st = xst;
    if (a.coop) xbar = xcd_barrier_post((unsigned*)(ws + WS_CTL) + CW_BAR, xst);
#ifndef ONLY
#define ONLY -1
#endif
#define IN(k) ((ONLY < 0 || ONLY == (k)) && lo <= (k) && (k) < hi)
#ifndef PROBE_PHASE
#define PROBE_PHASE -1
#endif
#define REPS(k) ((PROBE_PHASE == (k)) ? 2 : 1)
#define RLOOP(k) for (int rep = 0; rep < REPS(k); ++rep)
#define RSYNC(k) do { if (rep + 1 < REPS(k)) xcd_barrier(xbar); } while (0)
#define SEAM(k) do { if (a.coop && IN(k) && IN((k) + 1)) { if ((k) == 0) grid.sync(); else xcd_barrier(xbar); } } while (0)

    if (IN(0)) RLOOP(0) { p0_prologue(a, lds); RSYNC(0); }
    SEAM(0);
    if (IN(1)) RLOOP(1) {
        { pg8::Gemm g{(const bf16_t*)(ws + WS_H1), (const bf16_t*)(ws + WS_WIN), DM, DM, DM}; pg8::StaticOrder S; S.init(MT, INC, G, bid);
          pg8::EpiBf16 E{(bf16_t*)(ws + WS_Z), INC, nullptr, 1.0f}; pg8::gemm_phase<pg8::EpiBf16, pg8::StaticOrder, true>(lds, g, S, E); }
        { pg8::Gemm g{(const bf16_t*)(ws + WS_HM), (const bf16_t*)(ws + WS_WMKV), DM, DM, DM}; pg8::StaticOrder S; S.init(BP * NMEM, 2 * DM, G, G - 1 - bid);
          pg8::EpiMemKV E{a.out + O_MK, a.out + O_MV, (bf16_t*)(ws + WS_MKB), (bf16_t*)(ws + WS_VT)}; pg8::gemm_phase<pg8::EpiMemKV, pg8::StaticOrder, true>(lds, g, S, E); }
        RSYNC(1);
    }
    SEAM(1);
    RLOOP(2) {
    if (IN(2)) {
        for (int u = bid; u < BP * RH * 16; u += G) r1_unit(a, lds, u);
        for (int u = bid; u < BS * RH; u += G) rs_unit(a, lds, u);
        for (int r = bid; r < MT / 36; r += G) conv_block(a, r);
    }
    SEAM(2);
    if (IN(3)) {
        for (int u = bid; u < BP * RH * 16; u += G) { const int v = u & 255, bh = v >> 3, c = (u < 256) ? (v & 7) : 15 - (v & 7); r2_unit(a, lds, bh, c); }
    }
    RSYNC(2);
    }
    SEAM(3);
    if (IN(4)) {
        pg8::Gemm g{(const bf16_t*)(ws + WS_MIX), (const bf16_t*)(ws + WS_WMO), DM, DM, DM}; pg8::StaticOrder S; S.init(MT, DM, G, bid);
        pg8::EpiRes E{a.in[0], a.in[1], (float*)(ws + WS_X), (bf16_t*)(ws + WS_X1B), ctlf + CW_SSQ1}; pg8::gemm_phase<pg8::EpiRes, pg8::StaticOrder, true>(lds, g, S, E);
    }
    SEAM(4);
    if (IN(5)) RLOOP(5) {
        pg8::Gemm g{(const bf16_t*)(ws + WS_X1B), (const bf16_t*)(ws + WS_WXQ), DM, DM, DM}; pg8::StaticOrder S; S.init(MT, DM, G, bid);
        pg8::EpiBf16 E{(bf16_t*)(ws + WS_Q), DM, ctlf + CW_SSQ1, QSCALE}; pg8::gemm_phase<pg8::EpiBf16, pg8::StaticOrder, true>(lds, g, S, E);
        RSYNC(5);
    }
    SEAM(5);
    if (IN(6)) {
#ifndef NO_PA
        if (bid < BP * XH * 8) { const int u = bid, bh = u >> 3, rb = u & 7, b = bh >> 2, h = bh & 3;
#ifndef NO_PA1
            { pg8::Gemm g{(const bf16_t*)(ws + WS_Q) + h * XD, (const bf16_t*)(ws + WS_MKB) + h * XD, DM, DM, XD}; pg8::ListOrder S{b * 8 + rb, b, 1};
              pg8::EpiSoftmax E{(bf16_t*)(ws + WS_P), h}; pg8::gemm_phase<pg8::EpiSoftmax, pg8::ListOrder, false>(lds, g, S, E); }
#endif
            __threadfence(); __syncthreads();
            { pg8::Gemm g{(const bf16_t*)(ws + WS_P), (const bf16_t*)(ws + WS_VT), NMEM, NMEM, NMEM}; pg8::ListOrder S{bh * 8 + rb, bh * 2, 2};
              pg8::EpiPV E{(bf16_t*)(ws + WS_AO)}; pg8::gemm_phase<pg8::EpiPV, pg8::ListOrder, true>(lds, g, S, E); }
            __syncthreads();
        }
#endif
#ifndef NO_SA
        LAS unsigned* nxt = (LAS unsigned*)(lds + 140000);
        RLOOP(6) for (;;) { __syncthreads(); if (tid == 0) *nxt = atomicAdd((unsigned*)(ws + WS_CTL) + CW_ATT + rep, 1u); __syncthreads(); const unsigned u = *nxt; if (u >= (unsigned)(BS * XH)) break; sa_unit(a, lds, (int)u); }
#endif
    }
    SEAM(6);
    if (IN(7)) {
        pg8::Gemm g{(const bf16_t*)(ws + WS_AO), (const bf16_t*)(ws + WS_WXO), DM, DM, DM}; pg8::StaticOrder S; S.init(MT, DM, G, bid);
        pg8::EpiRes E{(const float*)(ws + WS_X), (const float*)(ws + WS_X) + (size_t)MP * DM, (float*)(ws + WS_X), (bf16_t*)(ws + WS_X2B), ctlf + CW_SSQ2}; pg8::gemm_phase<pg8::EpiRes, pg8::StaticOrder, true>(lds, g, S, E);
    }
    SEAM(7);
    if (IN(8)) RLOOP(8) {
        pg8::Gemm g{(const bf16_t*)(ws + WS_X2B), (const bf16_t*)(ws + WS_WGU), DM, DM, DM}; pg8::StaticOrder S; S.init(MT, 2 * DFF, G, bid);
        pg8::EpiSwiglu E{(bf16_t*)(ws + WS_HFF), ctlf + CW_SSQ2}; pg8::gemm_phase<pg8::EpiSwiglu, pg8::StaticOrder, true>(lds, g, S, E);
        RSYNC(8);
    }
    SEAM(8);
    if (IN(9)) {
        pg8::Gemm g{(const bf16_t*)(ws + WS_HFF), (const bf16_t*)(ws + WS_WD), DFF, DFF, DFF}; pg8::StaticOrder S; S.init(MT, DM, G, bid);
        pg8::EpiRes E{(const float*)(ws + WS_X), (const float*)(ws + WS_X) + (size_t)MP * DM, a.out + O_Y, nullptr, ctlf + CW_SSQ3}; pg8::gemm_phase<pg8::EpiRes, pg8::StaticOrder, true>(lds, g, S, E);
    }
    SEAM(9);
    if (IN(10)) {
        const float* ssq = ctlf + CW_SSQ3; const float* fg = a.in[22];
        for (int m = bid * 8 + wave; m < MT; m += G * 8) { const float rstd = rsqrtf(ssq[m] * (1.0f / DM) + RMS_EPS); f32x4* y = (f32x4*)(a.out + O_Y + (size_t)m * DM) + lane;
#pragma unroll
            for (int j = 0; j < 8; ++j) { const f32x4 gg = ((const f32x4*)fg)[lane + 64 * j]; f32x4 v = y[64 * j]; v = v * rstd * gg; y[64 * j] = v; } }
    }
#undef IN
#undef SEAM
}

constexpr int NPHASE = 11;
#ifndef MK_COOP
#define MK_COOP 1
#endif
extern "C" void kernel_launch(void* const* d_in, const int* in_sizes, int n_in, void* d_out, int out_size, void* d_ws, size_t ws_size, hipStream_t stream) {
    static int grid = 0;
    if (grid == 0) {
        if (n_in != 23 || ws_size < WS_END) { fprintf(stderr, "kernel_launch: unexpected inputs (n_in %d, ws %zu < %zu)\n", n_in, ws_size, (size_t)WS_END); grid = -1; return; }
        int dev = 0, cus = 0, per_cu = 0;
        (void)hipGetDevice(&dev); (void)hipDeviceGetAttribute(&cus, hipDeviceAttributeMultiprocessorCount, dev);
        (void)hipFuncSetAttribute((const void*)fwd_kernel, hipFuncAttributeMaxDynamicSharedMemorySize, LDS_BYTES);
        (void)hipOccupancyMaxActiveBlocksPerMultiprocessor(&per_cu, (const void*)fwd_kernel, NTHR, LDS_BYTES);
        if (per_cu < 1) per_cu = 1;
        grid = cus * per_cu;
        if (grid < 128) { fprintf(stderr, "kernel_launch: grid %d < 128 workgroups: unsupported device\n", grid); grid = -1; return; }
        (void)hipGetLastError();
    }
    if (grid < 0) return;
    (void)hipMemsetAsync((char*)d_ws + WS_CTL, 0, CTL_ZERO_BYTES, stream);
    Args a{};
    for (int i = 0; i < 23; ++i) a.in[i] = (const float*)d_in[i];
    a.out = (float*)d_out; a.ws = (unsigned char*)d_ws;
#if MK_COOP
    a.lo = 0; a.hi = NPHASE; a.coop = 1;
    void* args[] = {&a};
    hipError_t e = hipLaunchCooperativeKernel((const void*)fwd_kernel, dim3(grid), dim3(NTHR), args, LDS_BYTES, stream);
    if (e != hipSuccess) fprintf(stderr, "cooperative launch failed: %s (grid %d)\n", hipGetErrorString(e), grid);
#else
    for (int p = 0; p < NPHASE; ++p) { a.lo = p; a.hi = p + 1; a.coop = 0; hipLaunchKernelGGL(fwd_kernel, dim3(grid), dim3(NTHR), LDS_BYTES, stream, a); }
#endif
}
```

```cpp
#include <hip/hip_runtime.h>
#include <hip/hip_cooperative_groups.h>
#include <cstdio>
#include <cstdint>
namespace cg = cooperative_groups;

#define LAS __attribute__((address_space(3)))
typedef unsigned short bf16_t;
typedef short bf16x8 __attribute__((ext_vector_type(8)));
typedef float f32x4 __attribute__((ext_vector_type(4)));
typedef float f32x2 __attribute__((ext_vector_type(2)));
typedef unsigned u32x4 __attribute__((ext_vector_type(4)));
typedef unsigned u32x2 __attribute__((ext_vector_type(2)));

constexpr int DM = 2048, TP = 2048, BP = 4, MP = BP * TP, BS = 128, TS = 8, MS = BS * TS, MT = MP + MS;
constexpr int INC = 7168, RH = 8, RD = 128, NMEM = 256, XH = 4, XD = 512, DFF = 5632, PAST = 16384;
constexpr int ZQ = 0, ZK = 1024, ZV = 2048, ZG = 3072, ZBG = 4096, ZCG = 5120, ZHIN = 6144;
constexpr float RMS_EPS = 1e-6f, GN_EPS = 1e-5f;
constexpr float QSCALE = 0.04419417382415922f * 1.4426950408889634f;
constexpr float KSCALE = 0.08838834764831845f;
constexpr size_t O_Y = 0, O_SRP = (size_t)MT * DM, O_SRS = O_SRP + (size_t)BP * RH * RD * RD, O_SCP = O_SRS + (size_t)BS * RH * RD * RD,
                 O_SCS = O_SCP + (size_t)BP * 2 * 1024, O_MK = O_SCS + (size_t)BS * 2 * 1024, O_MV = O_MK + (size_t)BP * NMEM * DM;
constexpr size_t MiB = 1u << 20;
constexpr size_t WS_CTL = 0, WS_ROPE = 1 * MiB, WS_WIN = 4 * MiB, WS_WMO = WS_WIN + 28 * MiB, WS_WXQ = WS_WMO + 8 * MiB, WS_WXO = WS_WXQ + 8 * MiB,
                 WS_WMKV = WS_WXO + 8 * MiB, WS_WGU = WS_WMKV + 16 * MiB, WS_WD = WS_WGU + 44 * MiB, WS_H1 = WS_WD + 22 * MiB, WS_HM = WS_H1 + 36 * MiB,
                 WS_Z = WS_HM + 4 * MiB, WS_MIX = WS_Z + 126 * MiB, WS_X = WS_MIX + 36 * MiB, WS_X1B = WS_X + 72 * MiB, WS_Q = WS_X1B + 36 * MiB,
                 WS_P = WS_Q + 36 * MiB, WS_AO = WS_P + 16 * MiB, WS_X2B = WS_AO + 36 * MiB, WS_HFF = WS_X2B + 36 * MiB, WS_KV = WS_HFF + 99 * MiB,
                 WS_MKB = WS_KV + 32 * MiB, WS_VT = WS_MKB + 4 * MiB, WS_END = WS_VT + 4 * MiB;
constexpr int CW_SSQ1 = 0, CW_SSQ2 = 16384, CW_SSQ3 = 32768, CW_ATT = 49152, CW_N = 49152 + 64, CW_BAR = 65536;
constexpr size_t CTL_ZERO_BYTES = 512 * 1024;
constexpr int LDS_BYTES = 147456;
constexpr int NTHR = 512;

__device__ __forceinline__ unsigned f2bf(float f) { unsigned u = __builtin_bit_cast(unsigned, f); return (u + 0x7fffu + ((u >> 16) & 1u)) >> 16; }
__device__ __forceinline__ float bf2f(unsigned short h) { return __builtin_bit_cast(float, (unsigned)h << 16); }
typedef __bf16 bf16x2_t __attribute__((ext_vector_type(2)));
__device__ __forceinline__ unsigned pk2(float lo, float hi) { const f32x2 v = {lo, hi}; const bf16x2_t b = __builtin_convertvector(v, bf16x2_t); return __builtin_bit_cast(unsigned, b); }
__device__ __forceinline__ float bflo(unsigned w) { return __builtin_bit_cast(float, w << 16); }
__device__ __forceinline__ float bfhi(unsigned w) { return __builtin_bit_cast(float, w & 0xffff0000u); }
__device__ __forceinline__ float wave_sum(float v) {
#pragma unroll
    for (int o = 1; o < 64; o <<= 1) v += __shfl_xor(v, o);
    return v;
}
__device__ __forceinline__ float wave_max(float v) {
#pragma unroll
    for (int o = 1; o < 64; o <<= 1) v = fmaxf(v, __shfl_xor(v, o));
    return v;
}
__device__ __forceinline__ float silu_f(float x) { return x * __builtin_amdgcn_rcpf(1.0f + __builtin_amdgcn_exp2f(-1.4426950408889634f * x)); }
#define LDS_WAIT() asm volatile("s_waitcnt lgkmcnt(0)" ::: "memory")
__device__ __forceinline__ int opaque_tid() { int t = threadIdx.x; asm volatile("" : "+v"(t)); return t; }

namespace pg8 {
constexpr int BM = 256, BK = 64, HALF = 128, HTB = HALF * BK * 2, STAGE_BYTES = 8 * HTB, NXCD = 8, WGM = 8;
__host__ __device__ __forceinline__ int lds_byte(int r, int c) { const int st = (r >> 4) * 2 + (c >> 5), rr = r & 15, cc = c & 31, ob = rr * 64 + cc * 2; return st * 1024 + (ob ^ (((ob >> 9) & 1) << 5)); }
__host__ __device__ __forceinline__ void stage_rc(int b, int& R, int& C) { const int st = b / 1024, sb = b % 1024, swz = sb ^ (((sb >> 9) & 1) << 5); R = (st >> 1) * 16 + swz / 64; C = (st & 1) * 32 + (swz % 64) / 2; }
__host__ __device__ __forceinline__ int perm32(int rho) { const int n = rho >> 4, i = rho & 15; return 8 * (i >> 2) + 4 * n + (i & 3); }

struct Unit { int pm, pn; };
struct Gemm { const bf16_t* A; const bf16_t* Bt; int lda, ldb, K; };

struct StaticOrder {
    int nM, nN, nwg, G, c;
    __device__ void init(int M, int N, int G_, int c_) { nM = M / BM; nN = N / BM; nwg = nM * nN; G = G_; c = c_; }
    __device__ bool next(int i, Unit& u) const {
        const long L = (long)i * G + c; if (L >= nwg) return false;
        int wgid = (int)L; { const int q = nwg / NXCD, r = nwg % NXCD, xcd = wgid % NXCD, off = wgid / NXCD; wgid = (xcd < r ? xcd * (q + 1) : r * (q + 1) + (xcd - r) * q) + off; }
        const int nig = WGM * nN, gid = wgid / nig, fm = gid * WGM, gsz = (nM - fm) < WGM ? (nM - fm) : WGM;
        u.pm = fm + ((wgid % nig) % gsz); u.pn = (wgid % nig) / gsz; return true;
    }
};
struct ListOrder {
    int pm, pn0, n;
    __device__ bool next(int i, Unit& u) const { if (i >= n) return false; u.pm = pm; u.pn = pn0 + i; return true; }
};

template <class Epi, class Sched, bool ALIGN_EPI>
__device__ __forceinline__ void gemm_phase(LAS unsigned char* lds, const Gemm g, const Sched& S, const Epi& E) {
    const int tid = opaque_tid(), wid = __builtin_amdgcn_readfirstlane(tid >> 6), lane = tid & 63, wr = wid >> 2, wc = wid & 3, fr = lane & 15, fq = lane >> 4;
    int Kop = g.K; asm volatile("" : "+s"(Kop));
    const int K = Kop, nt = K / BK;
    unsigned voffA[2], voffB[2];
#pragma unroll
    for (int i = 0; i < 2; ++i) { int R, C; stage_rc(tid * 16 + i * 8192, R, C); const int Rb = Epi::PERM ? ((R & ~31) + perm32(R & 31)) : R;
        voffA[i] = (unsigned)(R * g.lda + C) * 2u; voffB[i] = (unsigned)(Rb * g.ldb + C) * 2u; }
    const size_t kstep = (size_t)(BK * 2);
    const size_t hstepA = (size_t)HALF * g.lda * 2, hstepB = (size_t)HALF * g.ldb * 2;
    const size_t tstepA = 2 * hstepA, tstepB = 2 * hstepB;
    const unsigned ldsw = (unsigned)wid * 1024u;
    const int aoff = lds_byte(wr * 64 + fr, fq * 8), boff = lds_byte(wc * 32 + fr, fq * 8);
#define PG8_SA(b, h) (((b) * 2 + (h)) * HTB)
#define PG8_SB(b, h) ((4 + (b) * 2 + (h)) * HTB)
#define PG8_STAGE(bufoff, gbase, voff) do { _Pragma("unroll") for (int _i = 0; _i < 2; ++_i) \
        __builtin_amdgcn_global_load_lds((const unsigned*)((const char*)(gbase) + (voff)[_i]), (LAS unsigned*)(lds + (bufoff) + ldsw + _i * 8192), 16, 0, 0); } while (0)
#define PG8_LDA(dst, b, h) do { _Pragma("unroll") for (int m = 0; m < 4; ++m) _Pragma("unroll") for (int k = 0; k < 2; ++k) dst[m][k] = *(const LAS bf16x8*)(lds + PG8_SA(b, h) + aoff + m * 2048 + k * 1024); } while (0)
#define PG8_LDB(dst, b, h) do { _Pragma("unroll") for (int n = 0; n < 2; ++n) _Pragma("unroll") for (int k = 0; k < 2; ++k) dst[n][k] = *(const LAS bf16x8*)(lds + PG8_SB(b, h) + boff + n * 2048 + k * 1024); } while (0)
#define PG8_MMA(ai, bj, At, Bt) do { __builtin_amdgcn_s_setprio(1); _Pragma("unroll") for (int m = 0; m < 4; ++m) _Pragma("unroll") for (int n = 0; n < 2; ++n) _Pragma("unroll") for (int k = 0; k < 2; ++k) \
        acc[ai][bj][m][n] = __builtin_amdgcn_mfma_f32_16x16x32_bf16(Bt[n][k], At[m][k], acc[ai][bj][m][n], 0, 0, 0); __builtin_amdgcn_s_setprio(0); } while (0)
#define PG8_WAIT_V(n) asm volatile("s_waitcnt vmcnt(" #n ")" ::: "memory")
#define PG8_WAIT_L(n) asm volatile("s_waitcnt lgkmcnt(" #n ")" ::: "memory")
#define PG8_BAR __builtin_amdgcn_s_barrier()
#define PG8_SCHED __builtin_amdgcn_sched_barrier(0)
    Unit cur, nxt; int ui = 0;
    if (!S.next(0, cur)) return;
    f32x4 acc[2][2][4][2];
#pragma unroll
    for (int a = 0; a < 2; ++a)
#pragma unroll
        for (int b = 0; b < 2; ++b)
#pragma unroll
            for (int m = 0; m < 4; ++m)
#pragma unroll
                for (int n = 0; n < 2; ++n) acc[a][b][m][n] = (f32x4){0.f, 0.f, 0.f, 0.f};
    bf16x8 At[4][2], B0[2][2], B1[2][2];
    const char* cA = (const char*)g.A + (size_t)cur.pm * tstepA; const char* cB = (const char*)g.Bt + (size_t)cur.pn * tstepB;
    PG8_STAGE(PG8_SB(0, 0), cB, voffB); PG8_STAGE(PG8_SB(0, 1), cB + hstepB, voffB); PG8_STAGE(PG8_SA(0, 0), cA, voffA); PG8_STAGE(PG8_SA(0, 1), cA + hstepA, voffA);
    if (wr == 1) PG8_BAR;
    PG8_WAIT_V(2); PG8_BAR;
    PG8_STAGE(PG8_SB(1, 0), cB + kstep, voffB); PG8_STAGE(PG8_SA(1, 0), cA + kstep, voffA); PG8_STAGE(PG8_SB(1, 1), cB + hstepB + kstep, voffB);
    PG8_WAIT_V(6); PG8_BAR;
    for (;;) {
        const bool has_next = S.next(ui + 1, nxt);
        const char* nA = has_next ? (const char*)g.A + (size_t)nxt.pm * tstepA : cA; const char* nB = has_next ? (const char*)g.Bt + (size_t)nxt.pn * tstepB : cB;
        for (int t = 0; t < nt; t += 2) {
            const bool last = (t == nt - 2);
            const char* a1 = cA + (size_t)(t + 1) * kstep;
            const char* a2 = last ? nA : cA + (size_t)(t + 2) * kstep; const char* b2 = last ? nB : cB + (size_t)(t + 2) * kstep;
            const char* a3 = a2 + kstep; const char* b3 = b2 + kstep;
            PG8_LDB(B0, 0, 0); PG8_LDB(B1, 0, 1); PG8_SCHED; PG8_LDA(At, 0, 0); PG8_STAGE(PG8_SA(1, 1), a1 + hstepA, voffA);
            PG8_WAIT_V(8); PG8_WAIT_L(0); PG8_BAR; PG8_MMA(0, 0, At, B0); PG8_MMA(0, 1, At, B1); PG8_BAR; PG8_SCHED;
            PG8_LDA(At, 0, 1); PG8_STAGE(PG8_SB(0, 0), b2, voffB); PG8_STAGE(PG8_SB(0, 1), b2 + hstepB, voffB); PG8_STAGE(PG8_SA(0, 0), a2, voffA);
            PG8_WAIT_V(8); PG8_WAIT_L(0); PG8_BAR; PG8_MMA(1, 0, At, B0); PG8_MMA(1, 1, At, B1); PG8_BAR; PG8_SCHED;
            PG8_LDB(B0, 1, 0); PG8_LDB(B1, 1, 1); PG8_SCHED; PG8_LDA(At, 1, 0); PG8_STAGE(PG8_SA(0, 1), a2 + hstepA, voffA);
            PG8_WAIT_V(8); PG8_WAIT_L(0); PG8_BAR; PG8_MMA(0, 0, At, B0); PG8_MMA(0, 1, At, B1); PG8_BAR; PG8_SCHED;
            PG8_LDA(At, 1, 1); PG8_STAGE(PG8_SB(1, 0), b3, voffB); PG8_STAGE(PG8_SB(1, 1), b3 + hstepB, voffB); PG8_STAGE(PG8_SA(1, 0), a3, voffA);
            PG8_WAIT_V(8); PG8_WAIT_L(0); PG8_BAR; PG8_MMA(1, 0, At, B0); PG8_MMA(1, 1, At, B1); PG8_BAR; PG8_SCHED;
        }
        if constexpr (ALIGN_EPI) { if (wr == 0) PG8_BAR; }
        if constexpr (!Epi::AFTER_DRAIN) { E(acc, cur, wr, wc, fr, fq); }
        if (!has_next) break;
#pragma unroll
        for (int a = 0; a < 2; ++a)
#pragma unroll
            for (int b = 0; b < 2; ++b)
#pragma unroll
                for (int m = 0; m < 4; ++m)
#pragma unroll
                    for (int n = 0; n < 2; ++n) acc[a][b][m][n] = (f32x4){0.f, 0.f, 0.f, 0.f};
        cur = nxt; cA = nA; cB = nB; ++ui;
        if constexpr (ALIGN_EPI) { if (wr == 1) PG8_BAR; }
    }
    PG8_WAIT_V(0);
    if constexpr (!ALIGN_EPI) { if (wr == 0) PG8_BAR; }
    PG8_BAR;
    if constexpr (Epi::AFTER_DRAIN) { E.fused(acc, cur, wr, wc, fr, fq, lds, wid, lane); }
#undef PG8_SA
#undef PG8_SB
#undef PG8_STAGE
#undef PG8_LDA
#undef PG8_LDB
#undef PG8_MMA
#undef PG8_WAIT_V
#undef PG8_WAIT_L
#undef PG8_BAR
#undef PG8_SCHED
}

typedef f32x4 Acc[2][2][4][2];

struct EpiBf16 {
    static constexpr bool PERM = true, AFTER_DRAIN = false;
    bf16_t* O; int ldc; const float* ssq; float mul;
    __device__ __forceinline__ void operator()(const Acc& acc, const Unit& u, int wr, int wc, int fr, int fq) const {
        const int row0 = u.pm * BM + wr * 64 + fr, col0 = u.pn * BM + wc * 32 + 8 * fq;
        float rsv[2][4];
#pragma unroll
        for (int ai = 0; ai < 2; ++ai)
#pragma unroll
            for (int m = 0; m < 4; ++m) rsv[ai][m] = ssq ? ssq[row0 + ai * HALF + m * 16] : 0.f;
#pragma unroll
        for (int ai = 0; ai < 2; ++ai)
#pragma unroll
            for (int m = 0; m < 4; ++m) { const int row = row0 + ai * HALF + m * 16; bf16_t* rowp = O + (size_t)row * ldc + col0;
                float sc = mul; if (ssq) sc *= rsqrtf(rsv[ai][m] * (1.0f / DM) + RMS_EPS);
#pragma unroll
                for (int bj = 0; bj < 2; ++bj) { const f32x4 v0 = acc[ai][bj][m][0] * sc, v1 = acc[ai][bj][m][1] * sc;
                    u32x4 w; w.x = pk2(v0[0], v0[1]); w.y = pk2(v0[2], v0[3]); w.z = pk2(v1[0], v1[1]); w.w = pk2(v1[2], v1[3]);
                    *(u32x4*)(rowp + bj * HALF) = w; } }
    }
};
struct EpiSwiglu {
    static constexpr bool PERM = true, AFTER_DRAIN = false;
    bf16_t* O; const float* ssq;
    __device__ __forceinline__ void operator()(const Acc& acc, const Unit& u, int wr, int wc, int fr, int fq) const {
        const int row0 = u.pm * BM + wr * 64 + fr, col0 = u.pn * HALF + wc * 32 + 8 * fq;
        float rsv[2][4];
#pragma unroll
        for (int ai = 0; ai < 2; ++ai)
#pragma unroll
            for (int m = 0; m < 4; ++m) rsv[ai][m] = ssq[row0 + ai * HALF + m * 16];
#pragma unroll
        for (int ai = 0; ai < 2; ++ai)
#pragma unroll
            for (int m = 0; m < 4; ++m) { const int row = row0 + ai * HALF + m * 16;
                const float rs = rsqrtf(rsv[ai][m] * (1.0f / DM) + RMS_EPS);
                float h[8];
#pragma unroll
                for (int n = 0; n < 2; ++n)
#pragma unroll
                    for (int e = 0; e < 4; ++e) { const float gg = acc[ai][0][m][n][e] * rs, uu = acc[ai][1][m][n][e] * rs; h[n * 4 + e] = silu_f(gg) * uu; }
                u32x4 w; w.x = pk2(h[0], h[1]); w.y = pk2(h[2], h[3]); w.z = pk2(h[4], h[5]); w.w = pk2(h[6], h[7]);
                *(u32x4*)(O + (size_t)row * DFF + col0) = w; }
    }
};
struct EpiRes {
    static constexpr bool PERM = false, AFTER_DRAIN = false;
    const float* res_p; const float* res_s;
    float* out; bf16_t* xb; float* ssq;
    __device__ __forceinline__ void operator()(const Acc& acc, const Unit& u, int wr, int wc, int fr, int fq) const {
        const int col0 = u.pn * BM + wc * 32 + 4 * fq;
        const float* rbase = (u.pm * BM < MP) ? res_p : (res_s - (size_t)MP * DM);
#pragma unroll
        for (int ai = 0; ai < 2; ++ai)
#pragma unroll
            for (int mp = 0; mp < 4; mp += 2) {
                f32x4 bs[2][2][2];
#pragma unroll
                for (int mm = 0; mm < 2; ++mm) { const size_t off = (size_t)(u.pm * BM + ai * HALF + wr * 64 + (mp + mm) * 16 + fr) * DM + col0;
#pragma unroll
                    for (int bj = 0; bj < 2; ++bj)
#pragma unroll
                        for (int n = 0; n < 2; ++n) bs[mm][bj][n] = *(const f32x4*)(rbase + off + bj * HALF + n * 16); }
#pragma unroll
                for (int mm = 0; mm < 2; ++mm) { const int m = mp + mm; const int row = u.pm * BM + ai * HALF + wr * 64 + m * 16 + fr; const size_t off = (size_t)row * DM + col0; float ss = 0.f;
#pragma unroll
                    for (int bj = 0; bj < 2; ++bj)
#pragma unroll
                        for (int n = 0; n < 2; ++n) { const size_t o2 = off + bj * HALF + n * 16; const f32x4 o = bs[mm][bj][n] + acc[ai][bj][m][n];
                            ss += (o[0] * o[0] + o[1] * o[1]) + (o[2] * o[2] + o[3] * o[3]);
                            *(f32x4*)(out + o2) = o;
                            if (xb) { u32x2 w; w.x = pk2(o[0], o[1]); w.y = pk2(o[2], o[3]); *(u32x2*)(xb + o2) = w; } }
                    ss += __shfl_xor(ss, 16); ss += __shfl_xor(ss, 32);
                    if (fq == 0) unsafeAtomicAdd(ssq + row, ss); }
                asm volatile("" ::: "memory"); }
    }
};
struct EpiMemKV {
    static constexpr bool PERM = false, AFTER_DRAIN = false;
    float* outk; float* outv; bf16_t* mkb; bf16_t* vt;
    __device__ __forceinline__ void operator()(const Acc& acc, const Unit& u, int wr, int wc, int fr, int fq) const {
        const int col0 = u.pn * BM + wc * 32 + 4 * fq; const bool isv = col0 >= DM;
#pragma unroll
        for (int ai = 0; ai < 2; ++ai)
#pragma unroll
            for (int m = 0; m < 4; ++m) { const int row = u.pm * BM + ai * HALF + wr * 64 + m * 16 + fr;
#pragma unroll
                for (int bj = 0; bj < 2; ++bj)
#pragma unroll
                    for (int n = 0; n < 2; ++n) { const int c = col0 + bj * HALF + n * 16; const f32x4 o = acc[ai][bj][m][n];
                        if (!isv) { *(f32x4*)(outk + (size_t)row * DM + c) = o; u32x2 w; w.x = pk2(o[0], o[1]); w.y = pk2(o[2], o[3]); *(u32x2*)(mkb + (size_t)row * DM + c) = w; }
                        else { const int cv = c - DM; *(f32x4*)(outv + (size_t)row * DM + cv) = o; const int b = row >> 8, key = row & 255, h = cv >> 9, d = cv & 511;
                            bf16_t* p = vt + ((size_t)((b * XH + h) * XD + d)) * NMEM + key;
                            p[0] = (bf16_t)f2bf(o[0]); p[NMEM] = (bf16_t)f2bf(o[1]); p[2 * NMEM] = (bf16_t)f2bf(o[2]); p[3 * NMEM] = (bf16_t)f2bf(o[3]); } } }
    }
};
struct EpiSoftmax {
    static constexpr bool PERM = true, AFTER_DRAIN = true;
    bf16_t* P; int h;
    __device__ __forceinline__ void fused(Acc& acc, const Unit& u, int wr, int wc, int fr, int fq, LAS unsigned char* lds, int wid, int lane) const {
        LAS float* red = (LAS float*)lds; LAS float* red2 = red + 1024;
#pragma unroll
        for (int ai = 0; ai < 2; ++ai)
#pragma unroll
            for (int m = 0; m < 4; ++m) { float v = -3.0e38f;
#pragma unroll
                for (int bj = 0; bj < 2; ++bj)
#pragma unroll
                    for (int n = 0; n < 2; ++n) { const f32x4 x = acc[ai][bj][m][n]; v = fmaxf(v, fmaxf(fmaxf(x[0], x[1]), fmaxf(x[2], x[3]))); }
                v = fmaxf(v, __shfl_xor(v, 16)); v = fmaxf(v, __shfl_xor(v, 32));
                if (fq == 0) red[(ai * HALF + wr * 64 + m * 16 + fr) * 4 + wc] = v; }
        LDS_WAIT(); __builtin_amdgcn_s_barrier(); asm volatile("" ::: "memory");
#pragma unroll
        for (int ai = 0; ai < 2; ++ai)
#pragma unroll
            for (int m = 0; m < 4; ++m) { const int r = ai * HALF + wr * 64 + m * 16 + fr; const f32x4 t = *(const LAS f32x4*)(red + r * 4);
                const float mx = fmaxf(fmaxf(t[0], t[1]), fmaxf(t[2], t[3])); float s = 0.f;
#pragma unroll
                for (int bj = 0; bj < 2; ++bj)
#pragma unroll
                    for (int n = 0; n < 2; ++n) { f32x4 x = acc[ai][bj][m][n];
#pragma unroll
                        for (int e = 0; e < 4; ++e) { x[e] = __builtin_amdgcn_exp2f(x[e] - mx); s += x[e]; }
                        acc[ai][bj][m][n] = x; }
                s += __shfl_xor(s, 16); s += __shfl_xor(s, 32);
                if (fq == 0) red2[r * 4 + wc] = s; }
        LDS_WAIT(); __builtin_amdgcn_s_barrier(); asm volatile("" ::: "memory");
        const int b = u.pm >> 3, rb = u.pm & 7;
#pragma unroll
        for (int ai = 0; ai < 2; ++ai)
#pragma unroll
            for (int m = 0; m < 4; ++m) { const int r = ai * HALF + wr * 64 + m * 16 + fr; const f32x4 t = *(const LAS f32x4*)(red2 + r * 4);
                const float inv = 1.0f / ((t[0] + t[1]) + (t[2] + t[3]));
                bf16_t* rowp = P + ((size_t)((b * XH + h) * TP + rb * BM + r)) * NMEM + wc * 32 + 8 * fq;
#pragma unroll
                for (int bj = 0; bj < 2; ++bj) { const f32x4 v0 = acc[ai][bj][m][0] * inv, v1 = acc[ai][bj][m][1] * inv;
                    u32x4 w; w.x = pk2(v0[0], v0[1]); w.y = pk2(v0[2], v0[3]); w.z = pk2(v1[0], v1[1]); w.w = pk2(v1[2], v1[3]);
                    *(u32x4*)(rowp + bj * HALF) = w; } }
        LDS_WAIT(); __builtin_amdgcn_s_barrier(); asm volatile("" ::: "memory");
    }
};
struct EpiPV {
    static constexpr bool PERM = true, AFTER_DRAIN = false;
    bf16_t* AO;
    __device__ __forceinline__ void operator()(const Acc& acc, const Unit& u, int wr, int wc, int fr, int fq) const {
        const int bh = u.pm >> 3, rb = u.pm & 7, b = bh >> 2, h = bh & 3, ct = u.pn & 1;
        const int row0 = b * TP + rb * BM + wr * 64 + fr, col0 = h * XD + ct * BM + wc * 32 + 8 * fq;
#pragma unroll
        for (int ai = 0; ai < 2; ++ai)
#pragma unroll
            for (int m = 0; m < 4; ++m) { bf16_t* rowp = AO + (size_t)(row0 + ai * HALF + m * 16) * DM + col0;
#pragma unroll
                for (int bj = 0; bj < 2; ++bj) { const f32x4 v0 = acc[ai][bj][m][0], v1 = acc[ai][bj][m][1];
                    u32x4 w; w.x = pk2(v0[0], v0[1]); w.y = pk2(v0[2], v0[3]); w.z = pk2(v1[0], v1[1]); w.w = pk2(v1[2], v1[3]);
                    *(u32x4*)(rowp + bj * HALF) = w; } }
    }
};
}


struct SEpiRes {
    const float* res; float* out; bf16_t* xb; float* ssq;
    __device__ __forceinline__ void operator()(const f32x4 (&acc)[4], int row, int col0, int fq) const {
        const size_t off = (size_t)row * DM + col0; f32x4 bs[4];
#pragma unroll
        for (int t = 0; t < 4; ++t) bs[t] = *(const f32x4*)(res + off + 16 * t);
        float ss = 0.f;
#pragma unroll
        for (int t = 0; t < 4; ++t) { const f32x4 o = bs[t] + acc[t]; ss += (o[0] * o[0] + o[1] * o[1]) + (o[2] * o[2] + o[3] * o[3]);
            *(f32x4*)(out + off + 16 * t) = o;
            if (xb) { u32x2 w; w.x = pk2(o[0], o[1]); w.y = pk2(o[2], o[3]); *(u32x2*)(xb + off + 16 * t) = w; } }
        ss += __shfl_xor(ss, 16); ss += __shfl_xor(ss, 32);
        if (fq == 0) unsafeAtomicAdd(ssq + row, ss);
    }
};
struct SEpiBf16 {
    bf16_t* O; const float* ssq; float mul;
    __device__ __forceinline__ void operator()(const f32x4 (&acc)[4], int row, int col0, int fq) const {
        const float sc = mul * rsqrtf(ssq[row] * (1.0f / DM) + RMS_EPS);
#pragma unroll
        for (int t = 0; t < 4; ++t) { const f32x4 o = acc[t] * sc; u32x2 w; w.x = pk2(o[0], o[1]); w.y = pk2(o[2], o[3]); *(u32x2*)(O + (size_t)row * DM + col0 + 16 * t) = w; }
    }
};
template <class SEpi>
__device__ __forceinline__ void small_gemm(LAS unsigned char* lds, const bf16_t* A, int lda, const bf16_t* Bt, int ldb, int K, int tile, const SEpi& E) {
    const int tid = opaque_tid(), lane = tid & 63, w = tid >> 6, fr = lane & 15, fq = lane >> 4;
    const int tm = tile >> 5, tn = tile & 31, nt = K >> 6;
    const bf16_t* Ap = A + (size_t)(tm * 128 + 16 * w + fr) * lda + 8 * fq;
    const bf16_t* Bp = Bt + (size_t)(tn * 64 + (tid >> 3)) * ldb + (tid & 7) * 8;
    const int wofs = (tid >> 3) * 144 + (tid & 7) * 16, rofs = fr * 144 + fq * 16;
    f32x4 acc[4];
#pragma unroll
    for (int t = 0; t < 4; ++t) acc[t] = (f32x4){0.f, 0.f, 0.f, 0.f};
    bf16x8 a0 = *(const bf16x8*)(Ap), a1 = *(const bf16x8*)(Ap + 32);
    { const u32x4 b = *(const u32x4*)(Bp); *(LAS u32x4*)(lds + wofs) = b; }
    __syncthreads();
    for (int kt = 0; kt < nt; ++kt) {
        const bool more = kt + 1 < nt;
        u32x4 bn = (u32x4){0u, 0u, 0u, 0u}; bf16x8 an0 = a0, an1 = a1;
        if (more) { bn = *(const u32x4*)(Bp + 64 * (kt + 1)); an0 = *(const bf16x8*)(Ap + 64 * (kt + 1)); an1 = *(const bf16x8*)(Ap + 64 * (kt + 1) + 32); }
        const LAS unsigned char* bb = lds + (kt & 1) * 9216 + rofs;
#pragma unroll
        for (int t = 0; t < 4; ++t) { const bf16x8 x0 = *(const LAS bf16x8*)(bb + t * 16 * 144), x1 = *(const LAS bf16x8*)(bb + t * 16 * 144 + 64);
            acc[t] = __builtin_amdgcn_mfma_f32_16x16x32_bf16(x0, a0, acc[t], 0, 0, 0); acc[t] = __builtin_amdgcn_mfma_f32_16x16x32_bf16(x1, a1, acc[t], 0, 0, 0); }
        if (more) *(LAS u32x4*)(lds + ((kt + 1) & 1) * 9216 + wofs) = bn;
        __syncthreads();
        a0 = an0; a1 = an1;
    }
    E(acc, tm * 128 + 16 * w + fr, tn * 64 + 4 * fq, fq);
}

struct Args { const float* in[23]; float* out; unsigned char* ws; int lo, hi, coop, pad; };

__device__ __forceinline__ void transpose_item(const float* W, int K, int N, bf16_t* WT, int drow, const float* gain, int k0, int n0, int lane) {
    const float* src = W + (size_t)k0 * N + n0 + lane;
    float v[64];
#pragma unroll
    for (int i = 0; i < 64; ++i) v[i] = src[(size_t)i * N];
    if (gain) {
#pragma unroll
        for (int i = 0; i < 64; ++i) v[i] *= gain[k0 + i];
    }
    bf16_t* dst = WT + (size_t)drow * K + k0;
#pragma unroll
    for (int c = 0; c < 8; ++c) { u32x4 o; o.x = pk2(v[8 * c], v[8 * c + 1]); o.y = pk2(v[8 * c + 2], v[8 * c + 3]); o.z = pk2(v[8 * c + 4], v[8 * c + 5]); o.w = pk2(v[8 * c + 6], v[8 * c + 7]);
        *(u32x4*)(dst + 8 * c) = o; }
}
__device__ __forceinline__ void rms_row_bf16(const float* x, const float* g, bf16_t* o, int lane) {
    const f32x4* xr = (const f32x4*)x + lane; f32x4 v[8]; float s = 0.f;
#pragma unroll
    for (int j = 0; j < 8; ++j) { v[j] = xr[64 * j]; s += (v[j][0] * v[j][0] + v[j][1] * v[j][1]) + (v[j][2] * v[j][2] + v[j][3] * v[j][3]); }
    const float rstd = rsqrtf(wave_sum(s) * (1.0f / DM) + RMS_EPS);
    const f32x4* gr = (const f32x4*)g + lane; u32x2* o8 = (u32x2*)o + lane;
    f32x4 ggv[8];
#pragma unroll
    for (int j = 0; j < 8; ++j) ggv[j] = gr[64 * j];
#pragma unroll
    for (int j = 0; j < 8; ++j) { const f32x4 gg = ggv[j]; u32x2 w; w.x = pk2(v[j][0] * rstd * gg[0], v[j][1] * rstd * gg[1]); w.y = pk2(v[j][2] * rstd * gg[2], v[j][3] * rstd * gg[3]); o8[64 * j] = w; }
}
__device__ __forceinline__ void p0_prologue(const Args& a, LAS unsigned char* lds) {
    const int tid = opaque_tid(), lane = tid & 63, wave = tid >> 6, G = gridDim.x;
    unsigned char* ws = a.ws;
    { unsigned* ctl = (unsigned*)(ws + WS_CTL); for (int i = blockIdx.x * NTHR + tid; i < CW_N; i += G * NTHR) ctl[i] = 0u; }
    { float* rc = (float*)(ws + WS_ROPE); float* rs = rc + 2056 * 64;
      for (int i = blockIdx.x * NTHR + tid; i < 2056 * 64; i += G * NTHR) { const int idx = i >> 6, f = i & 63; const int pos = idx < 2048 ? idx : PAST + idx - 2048;
          const float inv = exp2f(-(float)f * (13.287712379549449f / 64.0f)); const float ang = (float)pos * inv;
          const double ad = (double)ang; const double k = __builtin_rint(ad * 0.15915494309189535); const float r = (float)(ad - k * 6.283185307179586);
          rc[i] = cosf(r); rs[i] = sinf(r); } }
    const int gw = blockIdx.x * 8 + wave, NGW = G * 8;
    constexpr int I_IN = 32 * 112, I_SQ = 32 * 32, I_FF = 32 * 88, I_DN = 88 * 32;
    constexpr int NITEMS = I_IN + 5 * I_SQ + 2 * I_FF + I_DN;
    for (int it = gw; it < NITEMS; it += NGW) {
        int r = it;
        if (r < I_IN) { const int kb = r / 112, nb = r % 112; transpose_item(a.in[8], DM, INC, (bf16_t*)(ws + WS_WIN), nb * 64 + lane, nullptr, kb * 64, nb * 64, lane); continue; } r -= I_IN;
        if (r < 5 * I_SQ) { const int w = r / I_SQ, q = r % I_SQ, kb = q / 32, nb = q % 32;
            const float* src; bf16_t* dst; const float* gain = nullptr; int roff = 0;
            if (w == 0) { src = a.in[11]; dst = (bf16_t*)(ws + WS_WMO); }
            else if (w == 1) { src = a.in[14]; dst = (bf16_t*)(ws + WS_WXQ); gain = a.in[13]; }
            else if (w == 2) { src = a.in[15]; dst = (bf16_t*)(ws + WS_WMKV); }
            else if (w == 3) { src = a.in[16]; dst = (bf16_t*)(ws + WS_WMKV); roff = DM; }
            else { src = a.in[17]; dst = (bf16_t*)(ws + WS_WXO); }
            transpose_item(src, DM, DM, dst, roff + nb * 64 + lane, gain, kb * 64, nb * 64, lane); continue; } r -= 5 * I_SQ;
        if (r < 2 * I_FF) { const int w = r / I_FF, q = r % I_FF, kb = q / 88, nb = q % 88, n = nb * 64 + lane;
            transpose_item(w == 0 ? a.in[19] : a.in[20], DM, DFF, (bf16_t*)(ws + WS_WGU), (n >> 7) * 256 + w * 128 + (n & 127), a.in[18], kb * 64, nb * 64, lane); continue; } r -= 2 * I_FF;
        { const int kb = r / 32, nb = r % 32; transpose_item(a.in[21], DFF, DM, (bf16_t*)(ws + WS_WD), nb * 64 + lane, nullptr, kb * 64, nb * 64, lane); }
    }
    for (int m = gw; m < MT + BP * NMEM; m += NGW) {
        if (m < MP) rms_row_bf16(a.in[0] + (size_t)m * DM, a.in[7], (bf16_t*)(ws + WS_H1) + (size_t)m * DM, lane);
        else if (m < MT) rms_row_bf16(a.in[1] + (size_t)(m - MP) * DM, a.in[7], (bf16_t*)(ws + WS_H1) + (size_t)m * DM, lane);
        else rms_row_bf16(a.in[2] + (size_t)(m - MT) * DM, a.in[12], (bf16_t*)(ws + WS_HM) + (size_t)(m - MT) * DM, lane);
    }
}

constexpr int RP = 136;
constexpr int RTILE = 128 * RP * 2;
__device__ __forceinline__ bf16x8 rfrag(const LAS unsigned char* tile, int row, int ks, int fq) { return *(const LAS bf16x8*)(tile + (row * RP + 32 * ks + 8 * fq) * 2); }
__device__ __forceinline__ float ret_lg2(int h) { return log2f(1.0f - exp2f(-5.0f - (float)h)); }

template <bool TRANSPOSE> __device__ __forceinline__ void stage_rot(const bf16_t* Z, int r0, int coff, int posidx0, const float* ropeC, const float* ropeS, LAS unsigned char* dst, float scale, float lg2, bool decay) {
    const int tid = opaque_tid(), j = tid >> 2, dq = tid & 3;
    const bf16_t* src = Z + (size_t)(r0 + j) * INC + coff + 16 * dq;
    const u32x4 a0 = *(const u32x4*)(src), a1 = *(const u32x4*)(src + 8), b0 = *(const u32x4*)(src + 64), b1 = *(const u32x4*)(src + 72);
    const float* cs = ropeC + (size_t)(posidx0 + j) * 64 + 16 * dq; const float* sn = ropeS + (size_t)(posidx0 + j) * 64 + 16 * dq;
    float sc = scale; if (decay) sc *= exp2f((float)(127 - j) * lg2);
    float y1[16], y2[16];
#pragma unroll
    for (int e = 0; e < 16; ++e) { const unsigned wa = (e < 8) ? a0[(e & 7) >> 1] : a1[(e & 7) >> 1]; const unsigned wb = (e < 8) ? b0[(e & 7) >> 1] : b1[(e & 7) >> 1];
        const float x1 = (e & 1) ? bfhi(wa) : bflo(wa), x2 = (e & 1) ? bfhi(wb) : bflo(wb); const float c = cs[e], s = sn[e];
        y1[e] = (x1 * c - x2 * s) * sc; y2[e] = (x1 * s + x2 * c) * sc; }
    if (TRANSPOSE) {
        LAS bf16_t* d = (LAS bf16_t*)dst;
#pragma unroll
        for (int e = 0; e < 16; ++e) { d[(16 * dq + e) * RP + j] = (bf16_t)f2bf(y1[e]); d[(64 + 16 * dq + e) * RP + j] = (bf16_t)f2bf(y2[e]); }
    } else {
        LAS unsigned char* p = dst + (j * RP + 16 * dq) * 2;
        u32x4 w;
        w.x = pk2(y1[0], y1[1]); w.y = pk2(y1[2], y1[3]); w.z = pk2(y1[4], y1[5]); w.w = pk2(y1[6], y1[7]); *(LAS u32x4*)(p) = w;
        w.x = pk2(y1[8], y1[9]); w.y = pk2(y1[10], y1[11]); w.z = pk2(y1[12], y1[13]); w.w = pk2(y1[14], y1[15]); *(LAS u32x4*)(p + 16) = w;
        w.x = pk2(y2[0], y2[1]); w.y = pk2(y2[2], y2[3]); w.z = pk2(y2[4], y2[5]); w.w = pk2(y2[6], y2[7]); *(LAS u32x4*)(p + 128) = w;
        w.x = pk2(y2[8], y2[9]); w.y = pk2(y2[10], y2[11]); w.z = pk2(y2[12], y2[13]); w.w = pk2(y2[14], y2[15]); *(LAS u32x4*)(p + 144) = w;
    }
}
__device__ __forceinline__ void stage_vt(const bf16_t* Z, int r0, int coff, LAS unsigned char* dst) {
    const int tid = opaque_tid(), j = tid >> 2, eq = tid & 3;
    const bf16_t* src = Z + (size_t)(r0 + j) * INC + coff + 32 * eq;
    LAS bf16_t* d = (LAS bf16_t*)dst;
#pragma unroll
    for (int q = 0; q < 4; ++q) { const u32x4 v = *(const u32x4*)(src + 8 * q);
#pragma unroll
        for (int e = 0; e < 8; ++e) { const unsigned w = v[e >> 1]; d[(32 * eq + 8 * q + e) * RP + j] = (bf16_t)((e & 1) ? (w >> 16) : (w & 0xffffu)); } }
}

__device__ __forceinline__ void r1_unit(const Args& a, LAS unsigned char* lds, int unit) {
    const int tid = opaque_tid(), lane = tid & 63, w = tid >> 6, fr = lane & 15, fq = lane >> 4;
    const int bh = unit >> 4, c = unit & 15, b = bh >> 3, h = bh & 7;
    const bf16_t* Z = (const bf16_t*)(a.ws + WS_Z); const float* ropeC = (const float*)(a.ws + WS_ROPE); const float* ropeS = ropeC + 2056 * 64;
    const int r0 = b * TP + c * 128; const float lg2 = ret_lg2(h);
    LAS unsigned char* KT = lds + RTILE; LAS unsigned char* VT = lds + 2 * RTILE;
    stage_rot<true>(Z, r0, ZK + h * RD, c * 128, ropeC, ropeS, KT, KSCALE, lg2, true);
    stage_vt(Z, r0, ZV + h * RD, VT);
    __syncthreads();
    f32x4 acc[8];
#pragma unroll
    for (int t = 0; t < 8; ++t) acc[t] = (f32x4){0.f, 0.f, 0.f, 0.f};
#pragma unroll
    for (int ks = 0; ks < 4; ++ks) { const bf16x8 y = rfrag(VT, 16 * w + fr, ks, fq);
#pragma unroll
        for (int t = 0; t < 8; ++t) { const bf16x8 x = rfrag(KT, 16 * t + fr, ks, fq); acc[t] = __builtin_amdgcn_mfma_f32_16x16x32_bf16(x, y, acc[t], 0, 0, 0); } }
    float* kv = (float*)(a.ws + WS_KV) + ((size_t)unit * 128 + 16 * w + fr) * 128 + 4 * fq;
#pragma unroll
    for (int t = 0; t < 8; ++t) *(f32x4*)(kv + 16 * t) = acc[t];
    __syncthreads();
}

__device__ __forceinline__ void r2_unit(const Args& a, LAS unsigned char* lds, int bh, int c) {
    const int tid = opaque_tid(), lane = tid & 63, w = tid >> 6, fr = lane & 15, fq = lane >> 4;
    const int b = bh >> 3, h = bh & 7;
    const bf16_t* Z = (const bf16_t*)(a.ws + WS_Z); const float* ropeC = (const float*)(a.ws + WS_ROPE); const float* ropeS = ropeC + 2056 * 64;
    const int r0 = b * TP + c * 128; const float lg2 = ret_lg2(h);
    LAS unsigned char* QL = lds; LAS unsigned char* KL = lds + RTILE; LAS unsigned char* VT = lds + 2 * RTILE; LAS unsigned char* ST = lds + 3 * RTILE;
    stage_rot<false>(Z, r0, ZQ + h * RD, c * 128, ropeC, ropeS, QL, 1.0f, lg2, false);
    stage_rot<false>(Z, r0, ZK + h * RD, c * 128, ropeC, ropeS, KL, KSCALE, lg2, false);
    stage_vt(Z, r0, ZV + h * RD, VT);
    {
        const float cd = exp2f(128.0f * lg2);
        f32x4 s[8];
#pragma unroll
        for (int k = 0; k < 8; ++k) s[k] = (f32x4){0.f, 0.f, 0.f, 0.f};
        const float* kv = (const float*)(a.ws + WS_KV) + (size_t)(bh * 16) * 16384 + tid * 4;
        const float cd2 = cd * cd;
        int j = 0;
        for (; j + 2 <= c; j += 2) { f32x4 v0[8], v1[8];
#pragma unroll
            for (int k = 0; k < 8; ++k) { const float* p = kv + (size_t)j * 16384 + k * 2048; v0[k] = *(const f32x4*)(p); v1[k] = *(const f32x4*)(p + 16384); }
#pragma unroll
            for (int k = 0; k < 8; ++k) s[k] = s[k] * cd2 + (v0[k] * cd + v1[k]); }
        for (; j < c; ++j) { f32x4 v0[8];
#pragma unroll
            for (int k = 0; k < 8; ++k) v0[k] = *(const f32x4*)(kv + (size_t)j * 16384 + k * 2048);
#pragma unroll
            for (int k = 0; k < 8; ++k) s[k] = s[k] * cd + v0[k]; }
#pragma unroll
        for (int k = 0; k < 8; ++k) { const int idx = tid + 512 * k, e = idx >> 5, d4 = (idx & 31) * 4; u32x2 wv; wv.x = pk2(s[k][0], s[k][1]); wv.y = pk2(s[k][2], s[k][3]);
            *(LAS u32x2*)(ST + (e * RP + d4) * 2) = wv; }
        if (c == 15) {
            float* so = a.out + O_SRP + (size_t)bh * 16384;
            f32x4 vl[8];
#pragma unroll
            for (int k = 0; k < 8; ++k) vl[k] = *(const f32x4*)(kv + (size_t)15 * 16384 + k * 2048);
#pragma unroll
            for (int k = 0; k < 8; ++k) { const f32x4 f = s[k] * cd + vl[k];
                const int idx = tid + 512 * k, e = idx >> 5, d4 = (idx & 31) * 4;
                so[(d4 + 0) * 128 + e] = f[0]; so[(d4 + 1) * 128 + e] = f[1]; so[(d4 + 2) * 128 + e] = f[2]; so[(d4 + 3) * 128 + e] = f[3]; }
        }
    }
    __syncthreads();
    const int il = 16 * w + fr;
    bf16x8 yq[4];
#pragma unroll
    for (int ks = 0; ks < 4; ++ks) yq[ks] = rfrag(QL, il, ks, fq);
    f32x4 o[8], sc[8];
#pragma unroll
    for (int t = 0; t < 8; ++t) { o[t] = (f32x4){0.f, 0.f, 0.f, 0.f}; sc[t] = (f32x4){0.f, 0.f, 0.f, 0.f}; }
#pragma unroll
    for (int ks = 0; ks < 4; ++ks)
#pragma unroll
        for (int t = 0; t < 8; ++t) { const bf16x8 x = rfrag(ST, 16 * t + fr, ks, fq); o[t] = __builtin_amdgcn_mfma_f32_16x16x32_bf16(x, yq[ks], o[t], 0, 0, 0); }
    const float qd = exp2f((float)(il + 1) * lg2);
#pragma unroll
    for (int t = 0; t < 8; ++t) o[t] = o[t] * qd;
#pragma unroll
    for (int ks = 0; ks < 4; ++ks)
#pragma unroll
        for (int t = 0; t < 8; ++t) { const bf16x8 x = rfrag(KL, 16 * t + fr, ks, fq); sc[t] = __builtin_amdgcn_mfma_f32_16x16x32_bf16(x, yq[ks], sc[t], 0, 0, 0); }
    __syncthreads();
#pragma unroll
    for (int t = 0; t < 8; ++t) { float p[4];
#pragma unroll
        for (int r = 0; r < 4; ++r) { const int j = 16 * t + 4 * fq + r; p[r] = (j <= il) ? sc[t][r] * exp2f((float)(il - j) * lg2) : 0.f; }
        u32x2 wv; wv.x = pk2(p[0], p[1]); wv.y = pk2(p[2], p[3]); *(LAS u32x2*)(ST + (il * RP + 16 * t + 4 * fq) * 2) = wv; }
    LDS_WAIT();
#pragma unroll
    for (int ks = 0; ks < 4; ++ks) { const bf16x8 y = rfrag(ST, il, ks, fq);
#pragma unroll
        for (int t = 0; t < 8; ++t) { const bf16x8 x = rfrag(VT, 16 * t + fr, ks, fq); o[t] = __builtin_amdgcn_mfma_f32_16x16x32_bf16(x, y, o[t], 0, 0, 0); } }
    float s1 = 0.f;
#pragma unroll
    for (int t = 0; t < 8; ++t) s1 += (o[t][0] + o[t][1]) + (o[t][2] + o[t][3]);
    s1 += __shfl_xor(s1, 16); s1 += __shfl_xor(s1, 32);
    const float mu = s1 * (1.0f / 128.0f); float s2 = 0.f;
#pragma unroll
    for (int t = 0; t < 8; ++t) { o[t] = o[t] - mu; s2 += (o[t][0] * o[t][0] + o[t][1] * o[t][1]) + (o[t][2] * o[t][2] + o[t][3] * o[t][3]); }
    s2 += __shfl_xor(s2, 16); s2 += __shfl_xor(s2, 32);
    const float rstd = rsqrtf(s2 * (1.0f / 128.0f) + GN_EPS);
    const int row = r0 + il; const float* gn = a.in[10] + h * RD; const bf16_t* gz = Z + (size_t)row * INC + ZG + h * RD; bf16_t* mix = (bf16_t*)(a.ws + WS_MIX) + (size_t)row * DM + h * RD;
    f32x4 ggv[8]; u32x2 gwv[8];
#pragma unroll
    for (int t = 0; t < 8; ++t) { const int e0 = 16 * t + 4 * fq; ggv[t] = *(const f32x4*)(gn + e0); gwv[t] = *(const u32x2*)(gz + e0); }
#pragma unroll
    for (int t = 0; t < 8; ++t) { const int e0 = 16 * t + 4 * fq; const f32x4 gg = ggv[t]; const u32x2 gw = gwv[t];
        const float g0 = bflo(gw.x), g1 = bfhi(gw.x), g2 = bflo(gw.y), g3 = bfhi(gw.y);
        u32x2 wv; wv.x = pk2(silu_f(g0) * o[t][0] * rstd * gg[0], silu_f(g1) * o[t][1] * rstd * gg[1]); wv.y = pk2(silu_f(g2) * o[t][2] * rstd * gg[2], silu_f(g3) * o[t][3] * rstd * gg[3]);
        *(u32x2*)(mix + e0) = wv; }
    __syncthreads();
}

__device__ __forceinline__ void rs_unit(const Args& a, LAS unsigned char* lds, int unit) {
    const int tid = opaque_tid(), lane = tid & 63, w = tid >> 6;
    const int bs = unit >> 3, h = unit & 7; const float lg2 = ret_lg2(h);
    const bf16_t* Z = (const bf16_t*)(a.ws + WS_Z); const float* ropeC = (const float*)(a.ws + WS_ROPE); const float* ropeS = ropeC + 2056 * 64;
    const int r0 = MP + bs * TS;
    LAS float* qT = (LAS float*)lds;
    LAS float* kT = qT + 1024;
    LAS float* vL = kT + 1024;
    LAS float* scL = vL + 1024;
    LAS float* red = scL + 64;
    {
        const int which = tid >> 8, i = (tid >> 5) & 7, d = 2 * (tid & 31);
        const bf16_t* src = Z + (size_t)(r0 + i) * INC + (which ? ZK : ZQ) + h * RD + d;
        const unsigned wa = *(const unsigned*)src, wb = *(const unsigned*)(src + 64);
        const float* cs = ropeC + (size_t)(2048 + i) * 64 + d; const float* sn = ropeS + (size_t)(2048 + i) * 64 + d;
        const float sc = which ? KSCALE * exp2f((float)(7 - i) * lg2) : 1.0f;
        LAS float* dst = which ? kT : qT;
        { const float x1 = bflo(wa), x2 = bflo(wb), c = cs[0], s = sn[0]; dst[d * 8 + i] = (x1 * c - x2 * s) * sc; dst[(d + 64) * 8 + i] = (x1 * s + x2 * c) * sc; }
        { const float x1 = bfhi(wa), x2 = bfhi(wb), c = cs[1], s = sn[1]; dst[(d + 1) * 8 + i] = (x1 * c - x2 * s) * sc; dst[(d + 65) * 8 + i] = (x1 * s + x2 * c) * sc; }
        const int j = tid >> 6, e = 2 * (tid & 63); const unsigned wv = *(const unsigned*)(Z + (size_t)(r0 + j) * INC + ZV + h * RD + e);
        vL[j * 128 + e] = bflo(wv); vL[j * 128 + e + 1] = bfhi(wv);
    }
    __syncthreads();
    {
        const int pr = tid >> 3, i = pr >> 3, j = pr & 7, part = tid & 7; float s = 0.f;
#pragma unroll
        for (int d = 0; d < 16; ++d) s += qT[(part * 16 + d) * 8 + i] * kT[(part * 16 + d) * 8 + j];
        s += __shfl_xor(s, 1); s += __shfl_xor(s, 2); s += __shfl_xor(s, 4);
        if (part == 0) scL[i * 8 + j] = (j <= i) ? s * exp2f((float)(i - 7) * lg2) : 0.f;
    }
    {
        const int e = tid & 127, dg = tid >> 7; const float cd = exp2f(8.0f * lg2);
        float vr[8], cr[8];
#pragma unroll
        for (int j = 0; j < 8; ++j) { vr[j] = vL[j * 128 + e]; cr[j] = 0.f; }
        const float* s0 = a.in[3] + ((size_t)unit * 128 + dg * 32) * 128 + e; float* so = a.out + O_SRS + ((size_t)unit * 128 + dg * 32) * 128 + e;
        float sv[32];
#pragma unroll
        for (int d = 0; d < 32; ++d) sv[d] = s0[d * 128];
#pragma unroll
        for (int d = 0; d < 32; ++d) { const float s = sv[d]; const int dd = dg * 32 + d;
            const f32x4 q0 = *(const LAS f32x4*)(qT + dd * 8), q1 = *(const LAS f32x4*)(qT + dd * 8 + 4), k0 = *(const LAS f32x4*)(kT + dd * 8), k1 = *(const LAS f32x4*)(kT + dd * 8 + 4);
            float sn = s * cd;
#pragma unroll
            for (int i = 0; i < 4; ++i) { cr[i] += q0[i] * s; cr[i + 4] += q1[i] * s; sn += k0[i] * vr[i]; sn += k1[i] * vr[i + 4]; }
            so[d * 128] = sn; }
#pragma unroll
        for (int i = 0; i < 8; ++i) red[(dg * 8 + i) * 128 + e] = cr[i];
    }
    __syncthreads();
    {
        const int i = w; const float qd = exp2f((float)(i + 1) * lg2); float o[2];
#pragma unroll
        for (int q = 0; q < 2; ++q) { const int e = lane + 64 * q; float v = (red[(0 * 8 + i) * 128 + e] + red[(1 * 8 + i) * 128 + e]) + (red[(2 * 8 + i) * 128 + e] + red[(3 * 8 + i) * 128 + e]); v *= qd;
#pragma unroll
            for (int j = 0; j < 8; ++j) v += scL[i * 8 + j] * vL[j * 128 + e];
            o[q] = v; }
        const float mu = wave_sum(o[0] + o[1]) * (1.0f / 128.0f); o[0] -= mu; o[1] -= mu;
        const float rstd = rsqrtf(wave_sum(o[0] * o[0] + o[1] * o[1]) * (1.0f / 128.0f) + GN_EPS);
        const int row = r0 + i;
        const float gA = bf2f(Z[(size_t)row * INC + ZG + h * RD + lane]), gB = bf2f(Z[(size_t)row * INC + ZG + h * RD + lane + 64]);
        const float nA = a.in[10][h * RD + lane], nB = a.in[10][h * RD + lane + 64];
        ((bf16_t*)(a.ws + WS_MIX))[(size_t)row * DM + h * RD + lane] = (bf16_t)f2bf(silu_f(gA) * o[0] * rstd * nA);
        ((bf16_t*)(a.ws + WS_MIX))[(size_t)row * DM + h * RD + lane + 64] = (bf16_t)f2bf(silu_f(gB) * o[1] * rstd * nB);
    }
    __syncthreads();
}

__device__ __forceinline__ void conv_block(const Args& a, int blk) {
    const int tid = opaque_tid(), grp = tid >> 7, c = (tid & 127) * 8;
    const int r0 = blk * 36 + grp * 9;
    const bf16_t* Z = (const bf16_t*)(a.ws + WS_Z);
    u32x4 cgv[11], hnv[11], bgv[9];
#pragma unroll
    for (int i = 0; i < 11; ++i) { const int row = r0 - 2 + i;
        if (row >= 0) { const bf16_t* zr = Z + (size_t)row * INC; cgv[i] = *(const u32x4*)(zr + ZCG + c); hnv[i] = *(const u32x4*)(zr + ZHIN + c); }
        else { cgv[i] = (u32x4){0u, 0u, 0u, 0u}; hnv[i] = cgv[i]; } }
#pragma unroll
    for (int i = 0; i < 9; ++i) bgv[i] = *(const u32x4*)(Z + (size_t)(r0 + i) * INC + ZBG + c);
    const float* cw = a.in[9] + c;
    float w0[8], w1[8], w2[8];
    { const f32x4 x0 = *(const f32x4*)(cw), x1 = *(const f32x4*)(cw + 4), y0 = *(const f32x4*)(cw + 1024), y1 = *(const f32x4*)(cw + 1028), z0 = *(const f32x4*)(cw + 2048), z1 = *(const f32x4*)(cw + 2052);
#pragma unroll
      for (int e = 0; e < 4; ++e) { w0[e] = x0[e]; w0[e + 4] = x1[e]; w1[e] = y0[e]; w1[e + 4] = y1[e]; w2[e] = z0[e]; w2[e + 4] = z1[e]; } }
#pragma unroll
    for (int i = 0; i < 9; ++i) { const int row = r0 + i;
        int t, T; const float* cbuf = nullptr; float* sout;
        if (row < MP) { t = row & (TP - 1); T = TP; sout = a.out + O_SCP + (size_t)(row >> 11) * 2048; }
        else { const int r = row - MP; t = r & 7; T = TS; cbuf = a.in[4] + (size_t)(r >> 3) * 2048; sout = a.out + O_SCS + (size_t)(r >> 3) * 2048; }
        float u2[8], u1[8], u0[8];
#pragma unroll
        for (int e = 0; e < 8; ++e) { const unsigned wc2 = cgv[i + 2][e >> 1], wh2 = hnv[i + 2][e >> 1], wc1 = cgv[i + 1][e >> 1], wh1 = hnv[i + 1][e >> 1], wc0 = cgv[i][e >> 1], wh0 = hnv[i][e >> 1];
            u2[e] = (e & 1) ? bfhi(wc2) * bfhi(wh2) : bflo(wc2) * bflo(wh2);
            u1[e] = (e & 1) ? bfhi(wc1) * bfhi(wh1) : bflo(wc1) * bflo(wh1);
            u0[e] = (e & 1) ? bfhi(wc0) * bfhi(wh0) : bflo(wc0) * bflo(wh0); }
        if (t < 2) {
            if (cbuf) { const f32x4 p0 = *(const f32x4*)(cbuf + t * 1024 + c), p1 = *(const f32x4*)(cbuf + t * 1024 + c + 4);
#pragma unroll
                for (int e = 0; e < 4; ++e) { u0[e] = p0[e]; u0[e + 4] = p1[e]; }
                if (t == 0) { const f32x4 q0 = *(const f32x4*)(cbuf + 1024 + c), q1 = *(const f32x4*)(cbuf + 1024 + c + 4);
#pragma unroll
                    for (int e = 0; e < 4; ++e) { u1[e] = q0[e]; u1[e + 4] = q1[e]; } } }
            else {
#pragma unroll
                for (int e = 0; e < 8; ++e) { u0[e] = 0.f; if (t == 0) u1[e] = 0.f; } } }
        float o[8];
#pragma unroll
        for (int e = 0; e < 8; ++e) { const unsigned wb = bgv[i][e >> 1]; const float bg = (e & 1) ? bfhi(wb) : bflo(wb); o[e] = bg * (w0[e] * u0[e] + w1[e] * u1[e] + w2[e] * u2[e]); }
        u32x4 ow; ow.x = pk2(o[0], o[1]); ow.y = pk2(o[2], o[3]); ow.z = pk2(o[4], o[5]); ow.w = pk2(o[6], o[7]);
        *(u32x4*)((bf16_t*)(a.ws + WS_MIX) + (size_t)row * DM + 1024 + c) = ow;
        if (t >= T - 2) { float* sp = sout + (t - (T - 2)) * 1024 + c; *(f32x4*)(sp) = (f32x4){u2[0], u2[1], u2[2], u2[3]}; *(f32x4*)(sp + 4) = (f32x4){u2[4], u2[5], u2[6], u2[7]}; } }
}

__device__ __forceinline__ void sa_unit(const Args& a, LAS unsigned char* lds, int unit) {
    const int tid = opaque_tid(), lane = tid & 63, w = tid >> 6;
    const int bs = unit >> 2, h = unit & 3;
    LAS float* SL = (LAS float*)lds;
    LAS float* PT = SL + 2048;
    LAS float* OR = PT + 2048;
    const bf16_t* Qb = (const bf16_t*)(a.ws + WS_Q) + (size_t)(MP + bs * TS) * DM + h * XD;
    float q[8][8];
#pragma unroll
    for (int r = 0; r < 8; ++r) { const u32x2 w0 = *(const u32x2*)(Qb + (size_t)r * DM + 4 * lane), w1 = *(const u32x2*)(Qb + (size_t)r * DM + 256 + 4 * lane);
        q[r][0] = bflo(w0.x); q[r][1] = bfhi(w0.x); q[r][2] = bflo(w0.y); q[r][3] = bfhi(w0.y); q[r][4] = bflo(w1.x); q[r][5] = bfhi(w1.x); q[r][6] = bflo(w1.y); q[r][7] = bfhi(w1.y); }
    const float* Kb = a.in[5] + ((size_t)(bs * NMEM) * XH + h) * XD;
    const int rsel = 4 * (lane & 1) + 2 * ((lane >> 1) & 1) + ((lane >> 2) & 1);
    for (int kk = 0; kk < 32; kk += 4) {
        f32x4 k0[4], k1[4];
#pragma unroll
        for (int u = 0; u < 4; ++u) { const float* p = Kb + (size_t)(32 * w + kk + u) * (XH * XD); k0[u] = *(const f32x4*)(p + 4 * lane); k1[u] = *(const f32x4*)(p + 256 + 4 * lane); }
#pragma unroll
        for (int u = 0; u < 4; ++u) { float p8[8];
#pragma unroll
            for (int r = 0; r < 8; ++r) p8[r] = (q[r][0] * k0[u][0] + q[r][1] * k0[u][1]) + (q[r][2] * k0[u][2] + q[r][3] * k0[u][3]) + (q[r][4] * k1[u][0] + q[r][5] * k1[u][1]) + (q[r][6] * k1[u][2] + q[r][7] * k1[u][3]);
            float q4[4], q2[2], q1;
#pragma unroll
            for (int i = 0; i < 4; ++i) { const float send = (lane & 1) ? p8[i] : p8[i + 4], keep = (lane & 1) ? p8[i + 4] : p8[i]; q4[i] = keep + __shfl_xor(send, 1); }
#pragma unroll
            for (int i = 0; i < 2; ++i) { const float send = (lane & 2) ? q4[i] : q4[i + 2], keep = (lane & 2) ? q4[i + 2] : q4[i]; q2[i] = keep + __shfl_xor(send, 2); }
            { const float send = (lane & 4) ? q2[0] : q2[1], keep = (lane & 4) ? q2[1] : q2[0]; q1 = keep + __shfl_xor(send, 4); }
            q1 += __shfl_xor(q1, 8); q1 += __shfl_xor(q1, 16); q1 += __shfl_xor(q1, 32);
            if (lane < 8) SL[rsel * 256 + 32 * w + kk + u] = q1; }
    }
    __syncthreads();
    {
        float v[4]; float mx = -3.0e38f;
#pragma unroll
        for (int i = 0; i < 4; ++i) { v[i] = SL[w * 256 + lane + 64 * i]; mx = fmaxf(mx, v[i]); }
        mx = wave_max(mx); float s = 0.f;
#pragma unroll
        for (int i = 0; i < 4; ++i) { v[i] = __builtin_amdgcn_exp2f(v[i] - mx); s += v[i]; }
        const float inv = 1.0f / wave_sum(s);
#pragma unroll
        for (int i = 0; i < 4; ++i) PT[(lane + 64 * i) * 8 + w] = v[i] * inv;
    }
    __syncthreads();
    {
        const int g = tid >> 7, c = tid & 127;
        const float* Vb = a.in[6] + ((size_t)(bs * NMEM + g * 64) * XH + h) * XD + 4 * c;
        f32x4 acc[8];
#pragma unroll
        for (int r = 0; r < 8; ++r) acc[r] = (f32x4){0.f, 0.f, 0.f, 0.f};
        for (int k8 = 0; k8 < 64; k8 += 8) { f32x4 v[8];
#pragma unroll
            for (int u = 0; u < 8; ++u) v[u] = *(const f32x4*)(Vb + (size_t)(k8 + u) * (XH * XD));
#pragma unroll
            for (int u = 0; u < 8; ++u) { const int key = g * 64 + k8 + u; const f32x4 p0 = *(const LAS f32x4*)(PT + key * 8), p1 = *(const LAS f32x4*)(PT + key * 8 + 4);
#pragma unroll
                for (int r = 0; r < 4; ++r) { acc[r] = acc[r] + v[u] * p0[r]; acc[r + 4] = acc[r + 4] + v[u] * p1[r]; } } }
#pragma unroll
        for (int r = 0; r < 8; ++r) *(LAS f32x4*)(OR + (g * 8 + r) * 512 + 4 * c) = acc[r];
    }
    __syncthreads();
    {
        f32x4 s0 = (f32x4){0.f, 0.f, 0.f, 0.f}, s1 = s0;
#pragma unroll
        for (int g = 0; g < 4; ++g) { s0 = s0 + *(const LAS f32x4*)(OR + (g * 8 + w) * 512 + 8 * lane); s1 = s1 + *(const LAS f32x4*)(OR + (g * 8 + w) * 512 + 8 * lane + 4); }
        u32x4 o; o.x = pk2(s0[0], s0[1]); o.y = pk2(s0[2], s0[3]); o.z = pk2(s1[0], s1[1]); o.w = pk2(s1[2], s1[3]);
        *(u32x4*)((bf16_t*)(a.ws + WS_AO) + (size_t)(MP + bs * TS + w) * DM + h * XD + 8 * lane) = o;
    }
    __syncthreads();
}


#define XB_TMO      128
#define XB_XCNT(j)  (256  + 64 * (j))
#define XB_XSUB(j)  (1280 + 64 * (j))
#define XB_XGEN(j)  (2304 + 64 * (j))
#define XB_TOP      3328
#define XB_TOPGEN   3392
#define XCD_BAR_WORDS 3456
#define XB_SPIN_CAP (1u << 18)
__device__ __forceinline__ unsigned xb_ld(unsigned* p)              { return __hip_atomic_load(p, __ATOMIC_RELAXED, __HIP_MEMORY_SCOPE_AGENT); }
__device__ __forceinline__ unsigned xb_add(unsigned* p, unsigned v) { return __hip_atomic_fetch_add(p, v, __ATOMIC_RELAXED, __HIP_MEMORY_SCOPE_AGENT); }
__device__ __forceinline__ unsigned xb_xcc_id() { return (unsigned)__builtin_amdgcn_s_getreg((3 << 11) | 20) & 0xFu; }
#define XB_SPIN(cond, bar) do { unsigned _sp = 0; while (cond) { __builtin_amdgcn_s_sleep(1); \
    if ((++_sp & 255u) == 0u) { if (xb_ld(&(bar)[XB_TMO])) break; if (_sp > XB_SPIN_CAP) { atomicAdd(&(bar)[XB_TMO], 1u); break; } } } } while (0)
struct XcdBarrier { unsigned* bar; unsigned x; volatile LAS unsigned* st; };
__device__ __forceinline__ XcdBarrier xcd_barrier_post(unsigned* bar, volatile LAS unsigned* st) {
    XcdBarrier b; b.bar = bar; b.x = xb_xcc_id(); b.st = st;
    if (threadIdx.x == 0) (void)xb_add(&bar[XB_XCNT(b.x)], 1u);
    return b;
}
__device__ __forceinline__ void xcd_barrier_complete(unsigned* bar, unsigned x, unsigned& nloc, unsigned& nx) {
    const unsigned G = gridDim.x * gridDim.y * gridDim.z;
    unsigned sum, cnt, mine, sp = 0u;
    for (;;) {
        sum = 0u; cnt = 0u; mine = 0u;
#pragma unroll
        for (unsigned j = 0; j < 16; ++j) { const unsigned c = xb_ld(&bar[XB_XCNT(j)]); sum += c; cnt += (c > 0u) ? 1u : 0u; mine = (j == x) ? c : mine; }
        if (sum == G) break;
        __builtin_amdgcn_s_sleep(1);
        if ((++sp & 255u) == 0u) { if (xb_ld(&bar[XB_TMO])) break; if (sp > XB_SPIN_CAP) { atomicAdd(&bar[XB_TMO], 1u); break; } }
    }
    nloc = mine > 0u ? mine : 1u; nx = cnt > 0u ? cnt : 1u;
}
__device__ __forceinline__ void xcd_barrier(const XcdBarrier& b) {
    asm volatile("s_waitcnt vmcnt(0)" ::: "memory");
    __syncthreads();
    if (threadIdx.x == 0) {
        unsigned* bar = b.bar;
        __builtin_amdgcn_s_waitcnt(0);
        unsigned nloc = b.st[0], nx = b.st[1];
        if (nloc == 0u) { xcd_barrier_complete(bar, b.x, nloc, nx); b.st[0] = nloc; b.st[1] = nx; }
        const unsigned old = xb_add(&bar[XB_XSUB(b.x)], 1u);
        const unsigned gen = old / nloc;
        if (old + 1u == (gen + 1u) * nloc) {
            __builtin_amdgcn_fence(__ATOMIC_RELEASE, "agent");
            asm volatile("s_waitcnt vmcnt(0)" ::: "memory");
            const unsigned og = xb_add(&bar[XB_TOP], 1u);
            const unsigned tg = og / nx;
            if (og + 1u == (tg + 1u) * nx) xb_add(&bar[XB_TOPGEN], 1u);
            else XB_SPIN(xb_ld(&bar[XB_TOPGEN]) == tg, bar);
            __builtin_amdgcn_fence(__ATOMIC_ACQUIRE, "agent");
            xb_add(&bar[XB_XGEN(b.x)], 1u);
            asm volatile("s_waitcnt vmcnt(0)" ::: "memory");
        } else {
            XB_SPIN(xb_ld(&bar[XB_XGEN(b.x)]) == gen, bar);
            __builtin_amdgcn_fence(__ATOMIC_ACQUIRE, "agent");
            asm volatile("s_waitcnt vmcnt(0)" ::: "memory");
        }
    }
    __syncthreads();
}

__global__ void __launch_bounds__(NTHR, 2) fwd_kernel(Args a) {
    extern __shared__ __attribute__((aligned(16))) unsigned char lds_raw[];
    LAS unsigned char* lds = (LAS unsigned char*)lds_raw;
    cg::grid_group grid = cg::this_grid();
    const int tid = opaque_tid(), lane = tid & 63, wave = tid >> 6, G = gridDim.x, bid = blockIdx.x;
    unsigned char* ws = a.ws;
    float* ctlf = (float*)(ws + WS_CTL);
    const int lo = a.lo, hi = a.hi;
    volatile LAS unsigned* xst = (volatile LAS unsigned*)(lds + LDS_BYTES - 64);
    if (tid < 2) xst[tid] = 0u;
    __syncthreads();
    XcdBarrier xbar; xbar.bar = (unsigned*)(ws + WS_CTL) + CW_BAR; xbar.x = 0; xbar.st = xst;
    if (a.coop) xbar = xcd_barrier_post((unsigned*)(ws + WS_CTL) + CW_BAR, xst);
#ifndef ONLY
#define ONLY -1
#endif
#define IN(k) ((ONLY < 0 || ONLY == (k)) && lo <= (k) && (k) < hi)
#ifndef PROBE_PHASE
#define PROBE_PHASE -1
#endif
#define REPS(k) ((PROBE_PHASE == (k)) ? 2 : 1)
#define RLOOP(k) for (int rep = 0; rep < REPS(k); ++rep)
#define RSYNC(k) do { if (rep + 1 < REPS(k)) xcd_barrier(xbar); } while (0)
#define SEAM(k) do { if (a.coop && IN(k) && IN((k) + 1)) { if ((k) == 0) grid.sync(); else xcd_barrier(xbar); } } while (0)

    if (IN(0)) RLOOP(0) { p0_prologue(a, lds); RSYNC(0); }
    SEAM(0);
    if (IN(1)) RLOOP(1) {
        { pg8::Gemm g{(const bf16_t*)(ws + WS_H1), (const bf16_t*)(ws + WS_WIN), DM, DM, DM}; pg8::StaticOrder S; S.init(MT, INC, G, bid);
          pg8::EpiBf16 E{(bf16_t*)(ws + WS_Z), INC, nullptr, 1.0f}; pg8::gemm_phase<pg8::EpiBf16, pg8::StaticOrder, true>(lds, g, S, E); }
        { pg8::Gemm g{(const bf16_t*)(ws + WS_HM), (const bf16_t*)(ws + WS_WMKV), DM, DM, DM}; pg8::StaticOrder S; S.init(BP * NMEM, 2 * DM, G, G - 1 - bid);
          pg8::EpiMemKV E{a.out + O_MK, a.out + O_MV, (bf16_t*)(ws + WS_MKB), (bf16_t*)(ws + WS_VT)}; pg8::gemm_phase<pg8::EpiMemKV, pg8::StaticOrder, true>(lds, g, S, E); }
        RSYNC(1);
    }
    SEAM(1);
    RLOOP(2) {
    if (IN(2)) {
        for (int rp = 0; rp < REPS(20); ++rp) for (int u = bid; u < BP * RH * 16; u += G) r1_unit(a, lds, u);
        for (int rp = 0; rp < REPS(21); ++rp) for (int u = bid; u < BS * RH; u += G) rs_unit(a, lds, u);
        for (int rp = 0; rp < REPS(22); ++rp) for (int r = bid; r < MT / 36; r += G) conv_block(a, r);
    }
    SEAM(2);
    if (IN(3)) {
        for (int rp = 0; rp < REPS(23); ++rp) for (int u = bid; u < BP * RH * 16; u += G) { const int v = u & 255, bh = v >> 3, c = (u < 256) ? (v & 7) : 15 - (v & 7); r2_unit(a, lds, bh, c); }
    }
    RSYNC(2);
    }
    SEAM(3);
    if (IN(4)) {
        { pg8::Gemm g{(const bf16_t*)(ws + WS_MIX), (const bf16_t*)(ws + WS_WMO), DM, DM, DM}; pg8::StaticOrder S; S.init(MP, DM, G, bid);
          pg8::EpiRes E{a.in[0], a.in[1], (float*)(ws + WS_X), (bf16_t*)(ws + WS_X1B), ctlf + CW_SSQ1}; pg8::gemm_phase<pg8::EpiRes, pg8::StaticOrder, true>(lds, g, S, E); }
        { SEpiRes E{a.in[1], (float*)(ws + WS_X) + (size_t)MP * DM, (bf16_t*)(ws + WS_X1B) + (size_t)MP * DM, ctlf + CW_SSQ1 + MP};
          for (int t = bid; t < 256; t += G) small_gemm(lds, (const bf16_t*)(ws + WS_MIX) + (size_t)MP * DM, DM, (const bf16_t*)(ws + WS_WMO), DM, DM, t, E); }
    }
    SEAM(4);
    if (IN(5)) {
        { pg8::Gemm g{(const bf16_t*)(ws + WS_X1B), (const bf16_t*)(ws + WS_WXQ), DM, DM, DM}; pg8::StaticOrder S; S.init(MP, DM, G, bid);
          pg8::EpiBf16 E{(bf16_t*)(ws + WS_Q), DM, ctlf + CW_SSQ1, QSCALE}; pg8::gemm_phase<pg8::EpiBf16, pg8::StaticOrder, true>(lds, g, S, E); }
        { SEpiBf16 E{(bf16_t*)(ws + WS_Q) + (size_t)MP * DM, ctlf + CW_SSQ1 + MP, QSCALE};
          for (int t = bid; t < 256; t += G) small_gemm(lds, (const bf16_t*)(ws + WS_X1B) + (size_t)MP * DM, DM, (const bf16_t*)(ws + WS_WXQ), DM, DM, t, E); }
    }
    SEAM(5);
    if (IN(6)) {
#ifndef NO_PA
        if (bid < BP * XH * 8) { const int u = bid, bh = u >> 3, rb = u & 7, b = bh >> 2, h = bh & 3;
#ifndef NO_PA1
            { pg8::Gemm g{(const bf16_t*)(ws + WS_Q) + h * XD, (const bf16_t*)(ws + WS_MKB) + h * XD, DM, DM, XD}; pg8::ListOrder S{b * 8 + rb, b, 1};
              pg8::EpiSoftmax E{(bf16_t*)(ws + WS_P), h}; pg8::gemm_phase<pg8::EpiSoftmax, pg8::ListOrder, false>(lds, g, S, E); }
#endif
            __threadfence(); __syncthreads();
            { pg8::Gemm g{(const bf16_t*)(ws + WS_P), (const bf16_t*)(ws + WS_VT), NMEM, NMEM, NMEM}; pg8::ListOrder S{bh * 8 + rb, bh * 2, 2};
              pg8::EpiPV E{(bf16_t*)(ws + WS_AO)}; pg8::gemm_phase<pg8::EpiPV, pg8::ListOrder, true>(lds, g, S, E); }
            __syncthreads();
        }
#endif
#ifndef NO_SA
        LAS unsigned* nxt = (LAS unsigned*)(lds + 140000);
        RLOOP(6) for (;;) { __syncthreads(); if (tid == 0) *nxt = atomicAdd((unsigned*)(ws + WS_CTL) + CW_ATT + rep, 1u); __syncthreads(); const unsigned u = *nxt; if (u >= (unsigned)(BS * XH)) break; sa_unit(a, lds, (int)u); }
#endif
    }
    SEAM(6);
    if (IN(7)) {
        { pg8::Gemm g{(const bf16_t*)(ws + WS_AO), (const bf16_t*)(ws + WS_WXO), DM, DM, DM}; pg8::StaticOrder S; S.init(MP, DM, G, bid);
          pg8::EpiRes E{(const float*)(ws + WS_X), (const float*)(ws + WS_X) + (size_t)MP * DM, (float*)(ws + WS_X), (bf16_t*)(ws + WS_X2B), ctlf + CW_SSQ2}; pg8::gemm_phase<pg8::EpiRes, pg8::StaticOrder, true>(lds, g, S, E); }
        { SEpiRes E{(const float*)(ws + WS_X) + (size_t)MP * DM, (float*)(ws + WS_X) + (size_t)MP * DM, (bf16_t*)(ws + WS_X2B) + (size_t)MP * DM, ctlf + CW_SSQ2 + MP};
          for (int t = bid; t < 256; t += G) small_gemm(lds, (const bf16_t*)(ws + WS_AO) + (size_t)MP * DM, DM, (const bf16_t*)(ws + WS_WXO), DM, DM, t, E); }
    }
    SEAM(7);
    if (IN(8)) RLOOP(8) {
        pg8::Gemm g{(const bf16_t*)(ws + WS_X2B), (const bf16_t*)(ws + WS_WGU), DM, DM, DM}; pg8::StaticOrder S; S.init(MT, 2 * DFF, G, bid);
        pg8::EpiSwiglu E{(bf16_t*)(ws + WS_HFF), ctlf + CW_SSQ2}; pg8::gemm_phase<pg8::EpiSwiglu, pg8::StaticOrder, true>(lds, g, S, E);
        RSYNC(8);
    }
    SEAM(8);
    if (IN(9)) {
        { pg8::Gemm g{(const bf16_t*)(ws + WS_HFF), (const bf16_t*)(ws + WS_WD), DFF, DFF, DFF}; pg8::StaticOrder S; S.init(MP, DM, G, bid);
          pg8::EpiRes E{(const float*)(ws + WS_X), (const float*)(ws + WS_X) + (size_t)MP * DM, a.out + O_Y, nullptr, ctlf + CW_SSQ3}; pg8::gemm_phase<pg8::EpiRes, pg8::StaticOrder, true>(lds, g, S, E); }
        { SEpiRes E{(const float*)(ws + WS_X) + (size_t)MP * DM, a.out + O_Y + (size_t)MP * DM, nullptr, ctlf + CW_SSQ3 + MP};
          for (int t = bid; t < 256; t += G) small_gemm(lds, (const bf16_t*)(ws + WS_HFF) + (size_t)MP * DFF, DFF, (const bf16_t*)(ws + WS_WD), DFF, DFF, t, E); }
    }
    SEAM(9);
    if (IN(10)) {
        const float* ssq = ctlf + CW_SSQ3; const float* fg = a.in[22];
        for (int m = bid * 8 + wave; m < MT; m += G * 8) { const float rstd = rsqrtf(ssq[m] * (1.0f / DM) + RMS_EPS); f32x4* y = (f32x4*)(a.out + O_Y + (size_t)m * DM) + lane;
            f32x4 v[8], gg[8];
#pragma unroll
            for (int j = 0; j < 8; ++j) { gg[j] = ((const f32x4*)fg)[lane + 64 * j]; v[j] = y[64 * j]; }
#pragma unroll
            for (int j = 0; j < 8; ++j) y[64 * j] = v[j] * rstd * gg[j]; }
    }
#undef IN
#undef SEAM
}

constexpr int NPHASE = 11;
#ifndef MK_COOP
#define MK_COOP 1
#endif
extern "C" void kernel_launch(void* const* d_in, const int* in_sizes, int n_in, void* d_out, int out_size, void* d_ws, size_t ws_size, hipStream_t stream) {
    static int grid = 0;
    if (grid == 0) {
        if (n_in != 23 || ws_size < WS_END) { fprintf(stderr, "kernel_launch: unexpected inputs (n_in %d, ws %zu < %zu)\n", n_in, ws_size, (size_t)WS_END); grid = -1; return; }
        int dev = 0, cus = 0, per_cu = 0;
        (void)hipGetDevice(&dev); (void)hipDeviceGetAttribute(&cus, hipDeviceAttributeMultiprocessorCount, dev);
        (void)hipFuncSetAttribute((const void*)fwd_kernel, hipFuncAttributeMaxDynamicSharedMemorySize, LDS_BYTES);
        (void)hipOccupancyMaxActiveBlocksPerMultiprocessor(&per_cu, (const void*)fwd_kernel, NTHR, LDS_BYTES);
        if (per_cu < 1) per_cu = 1;
        grid = cus * per_cu;
        if (grid < 128) { fprintf(stderr, "kernel_launch: grid %d < 128 workgroups: unsupported device\n", grid); grid = -1; return; }
        (void)hipGetLastError();
    }
    if (grid < 0) return;
    (void)hipMemsetAsync((char*)d_ws + WS_CTL, 0, CTL_ZERO_BYTES, stream);
    Args a{};
    for (int i = 0; i < 23; ++i) a.in[i] = (const float*)d_in[i];
    a.out = (float*)d_out; a.ws = (unsigned char*)d_ws;
#if MK_COOP
    a.lo = 0; a.hi = NPHASE; a.coop = 1;
    void* args[] = {&a};
    hipError_t e = hipLaunchCooperativeKernel((const void*)fwd_kernel, dim3(grid), dim3(NTHR), args, LDS_BYTES, stream);
    if (e != hipSuccess) fprintf(stderr, "cooperative launch failed: %s (grid %d)\n", hipGetErrorString(e), grid);
#else
    for (int p = 0; p < NPHASE; ++p) { a.lo = p; a.hi = p + 1; a.coop = 0; hipLaunchKernelGGL(fwd_kernel, dim3(grid), dim3(NTHR), LDS_BYTES, stream, a); }
#endif
}
```
